# Optimizing an MI355X kernel written in HIP

```python
import math
import jax, jax.numpy as jnp
from jax import lax
import numpy as np

D_MODEL = 1024
BATCH = 2
SEQ = 8192
DEPTH = 2

N_A_LAYERS = DEPTH // 2
N_B_LAYERS = DEPTH - N_A_LAYERS
SB_HEADS = 16
SB_HEAD_DIM = D_MODEL // SB_HEADS
DIFF_HEAD_DIM = 64
DIFF_HEADS = D_MODEL // (2 * DIFF_HEAD_DIM)
DIFF_V_DIM = 2 * DIFF_HEAD_DIM
ROPE_THETA = 10000.0
Q_BLOCK = 128
EPS = 1e-6

kernel_name = "yoco_stickbreak_diffattn_hybrid"


def rms_norm(x, g):
    xf = x.astype(jnp.float32)
    y = xf * lax.rsqrt(jnp.mean(xf * xf, axis=-1, keepdims=True) + EPS) * g.astype(jnp.float32)
    return y.astype(x.dtype)


def rope_tables(positions, dim):
    inv_freq = ROPE_THETA ** (-jnp.arange(0, dim, 2, dtype=jnp.float32) / dim)
    ang = positions.astype(jnp.float32)[..., None] * inv_freq
    return jnp.cos(ang), jnp.sin(ang)


def apply_rope(t, cos, sin):
    tf = t.astype(jnp.float32)
    t1, t2 = jnp.split(tf, 2, axis=-1)
    out = jnp.concatenate([t1 * cos - t2 * sin, t2 * cos + t1 * sin], axis=-1)
    return out.astype(t.dtype)


def stick_breaking_attention(q, k, v):
    B, H, S, D = q.shape
    nb = S // Q_BLOCK
    scale = 1.0 / math.sqrt(D)
    qb = q.reshape(B, H, nb, Q_BLOCK, D).transpose(2, 0, 1, 3, 4)
    starts = jnp.arange(nb, dtype=jnp.int32) * Q_BLOCK
    key_pos = jnp.arange(S, dtype=jnp.int32)
    kf = k.astype(jnp.float32)
    vf = v.astype(jnp.float32)

    def block(args):
        qblk, t0 = args
        z = jnp.einsum('bhqd,bhkd->bhqk', qblk.astype(jnp.float32), kf) * scale
        tq = t0 + jnp.arange(Q_BLOCK, dtype=jnp.int32)
        strict = key_pos[None, :] < tq[:, None]
        log_1m = jnp.where(strict, jax.nn.log_sigmoid(-z), 0.0)
        suffix = lax.cumsum(log_1m, axis=3, reverse=True) - log_1m
        a = jnp.where(strict, jnp.exp(jax.nn.log_sigmoid(z) + suffix), 0.0)
        return jnp.einsum('bhqk,bhkd->bhqd', a, vf)

    out = lax.map(block, (qb, starts))
    return out.transpose(1, 2, 0, 3, 4).reshape(B, H, S, D)


def differential_attention(q, k, v, lam):
    B, H, _, S, Dh = q.shape
    nb = S // Q_BLOCK
    scale = 1.0 / math.sqrt(Dh)
    qb = q.reshape(B, H, 2, nb, Q_BLOCK, Dh).transpose(3, 0, 1, 2, 4, 5)
    starts = jnp.arange(nb, dtype=jnp.int32) * Q_BLOCK
    key_pos = jnp.arange(S, dtype=jnp.int32)
    kf = k.astype(jnp.float32)
    vf = v.astype(jnp.float32)

    def block(args):
        qblk, t0 = args
        s = jnp.einsum('bhcqd,bhckd->bhcqk', qblk.astype(jnp.float32), kf) * scale
        tq = t0 + jnp.arange(Q_BLOCK, dtype=jnp.int32)
        causal = key_pos[None, :] <= tq[:, None]
        p = jax.nn.softmax(jnp.where(causal, s, -jnp.inf), axis=-1)
        a = p[:, :, 0] - lam * p[:, :, 1]
        return jnp.einsum('bhqk,bhke->bhqe', a, vf)

    out = lax.map(block, (qb, starts))
    return out.transpose(1, 2, 0, 3, 4).reshape(B, H, S, 2 * Dh)


def stick_breaking_layer(x, norm_g, w_in, w_out):
    B, S, _ = x.shape
    h = rms_norm(x, norm_g)
    q, k, v, gate = jnp.split(h @ w_in, 4, axis=-1)

    def heads(t):
        return t.reshape(B, S, SB_HEADS, SB_HEAD_DIM).transpose(0, 2, 1, 3)

    o = stick_breaking_attention(heads(q), heads(k), heads(v))
    o = o.transpose(0, 2, 1, 3).reshape(B, S, D_MODEL).astype(x.dtype)
    return (jax.nn.silu(gate) * o) @ w_out


def shared_kv(x, kv_norm_g, w_kv, k_norm_g, cos, sin):
    B, S, _ = x.shape
    h = rms_norm(x, kv_norm_g)
    k, v = jnp.split(h @ w_kv, 2, axis=-1)
    k = k.reshape(B, S, DIFF_HEADS, 2, DIFF_HEAD_DIM)
    k = apply_rope(rms_norm(k, k_norm_g), cos[:, :, None, None, :], sin[:, :, None, None, :])
    k = k.transpose(0, 2, 3, 1, 4)
    v = v.reshape(B, S, DIFF_HEADS, DIFF_V_DIM).transpose(0, 2, 1, 3)
    return k, v


def diff_layer(x, k, v, norm_g, w_in, q_norm_g, lam_params, subln_g, w_out, layer_idx, cos, sin):
    B, S, _ = x.shape
    h = rms_norm(x, norm_g)
    q, gate = jnp.split(h @ w_in, 2, axis=-1)
    q = q.reshape(B, S, DIFF_HEADS, 2, DIFF_HEAD_DIM)
    q = apply_rope(rms_norm(q, q_norm_g), cos[:, :, None, None, :], sin[:, :, None, None, :])
    q = q.transpose(0, 2, 3, 1, 4)
    lam_init = 0.8 - 0.6 * math.exp(-0.3 * layer_idx)
    lf = lam_params.astype(jnp.float32)
    lam = jnp.exp(jnp.sum(lf[0] * lf[1])) - jnp.exp(jnp.sum(lf[2] * lf[3])) + lam_init
    o = differential_attention(q, k, v, lam)
    o = rms_norm(o, subln_g) * (1.0 - lam_init)
    o = o.transpose(0, 2, 1, 3).reshape(B, S, D_MODEL).astype(x.dtype)
    return (jax.nn.silu(gate) * o) @ w_out


def setup_inputs(seed: int = 0) -> dict:
    key = jax.random.key(seed)
    ks = jax.random.split(key, 16)
    d = D_MODEL
    s_in = d ** -0.5
    x = jax.random.normal(ks[0], (BATCH, SEQ, d), jnp.float32)
    positions = jnp.broadcast_to(jnp.arange(SEQ, dtype=jnp.int32)[None, :], (BATCH, SEQ))
    a_norm_g = 1.0 + 0.02 * jax.random.normal(ks[1], (N_A_LAYERS, d), jnp.float32)
    a_w_in = jax.random.normal(ks[2], (N_A_LAYERS, d, 4 * d), jnp.float32) * s_in
    a_w_out = jax.random.normal(ks[3], (N_A_LAYERS, d, d), jnp.float32) * s_in
    kv_norm_g = 1.0 + 0.02 * jax.random.normal(ks[4], (d,), jnp.float32)
    w_kv = jax.random.normal(ks[5], (d, 2 * d), jnp.float32) * s_in
    k_norm_g = 1.0 + 0.02 * jax.random.normal(ks[6], (DIFF_HEAD_DIM,), jnp.float32)
    b_norm_g = 1.0 + 0.02 * jax.random.normal(ks[7], (N_B_LAYERS, d), jnp.float32)
    b_w_in = jax.random.normal(ks[8], (N_B_LAYERS, d, 2 * d), jnp.float32) * s_in
    b_q_norm_g = 1.0 + 0.02 * jax.random.normal(ks[9], (N_B_LAYERS, DIFF_HEAD_DIM), jnp.float32)
    b_lambda = 0.1 * jax.random.normal(ks[10], (N_B_LAYERS, 4, DIFF_HEAD_DIM), jnp.float32)
    b_subln_g = 1.0 + 0.02 * jax.random.normal(ks[11], (N_B_LAYERS, DIFF_V_DIM), jnp.float32)
    b_w_out = jax.random.normal(ks[12], (N_B_LAYERS, d, d), jnp.float32) * s_in
    return {"x": x, "positions": positions, "a_norm_g": a_norm_g, "a_w_in": a_w_in,
            "a_w_out": a_w_out, "kv_norm_g": kv_norm_g, "w_kv": w_kv, "k_norm_g": k_norm_g,
            "b_norm_g": b_norm_g, "b_w_in": b_w_in, "b_q_norm_g": b_q_norm_g,
            "b_lambda": b_lambda, "b_subln_g": b_subln_g, "b_w_out": b_w_out}


def reference(x, positions, a_norm_g, a_w_in, a_w_out, kv_norm_g, w_kv, k_norm_g,
              b_norm_g, b_w_in, b_q_norm_g, b_lambda, b_subln_g, b_w_out):
    cos, sin = rope_tables(positions, DIFF_HEAD_DIM)
    k_shared = None
    v_shared = None
    for layer in range(DEPTH):
        if layer < N_A_LAYERS:
            x = x + stick_breaking_layer(x, a_norm_g[layer], a_w_in[layer], a_w_out[layer])
        else:
            if layer == N_A_LAYERS:
                k_shared, v_shared = shared_kv(x, kv_norm_g, w_kv, k_norm_g, cos, sin)
            j = layer - N_A_LAYERS
            x = x + diff_layer(x, k_shared, v_shared, b_norm_g[j], b_w_in[j], b_q_norm_g[j],
                               b_lambda[j], b_subln_g[j], b_w_out[j], layer, cos, sin)
    return x
```

```cpp
#include <hip/hip_runtime.h>
#include <hip/hip_cooperative_groups.h>
#include <cstdio>
#include <cstdint>
#include <cmath>
namespace cg = cooperative_groups;
namespace pg8 {
#define PG8_LAS __attribute__((address_space(3)))
typedef unsigned short bf16_t;
typedef short bf16x8 __attribute__((ext_vector_type(8)));
typedef float f32x4 __attribute__((ext_vector_type(4)));
typedef unsigned u32x4 __attribute__((ext_vector_type(4)));
constexpr int BM = 256, BK = 64, HALF = 128, HTB = HALF * BK * 2  , STAGE_BYTES = 8 * HTB, NXCD = 8, WGM = 8;

__host__ __device__ __forceinline__ int lds_byte(int r, int c) { const int st = (r >> 4) * 2 + (c >> 5), rr = r & 15, cc = c & 31, ob = rr * 64 + cc * 2; return st * 1024 + (ob ^ (((ob >> 9) & 1) << 5)); }
__host__ __device__ __forceinline__ void stage_rc(int b, int& R, int& C) { const int st = b / 1024, sb = b % 1024, swz = sb ^ (((sb >> 9) & 1) << 5); R = (st >> 1) * 16 + swz / 64; C = (st & 1) * 32 + (swz % 64) / 2; }
__host__ __device__ __forceinline__ int perm32(int rho) { const int n = rho >> 4, i = rho & 15; return 8 * (i >> 2) + 4 * n + (i & 3); }

struct Unit { int pm, pn; };
struct Gemm { const bf16_t* A; const bf16_t* Bt; int M, N, K; };

struct StaticOrder {
    int nM, nN, nwg, G, c;
    __host__ __device__ void init(int M, int N, int G_, int c_) { nM = M / BM; nN = N / BM; nwg = nM * nN; G = G_; c = c_; }
    __host__ __device__ bool next(int i, Unit& u) const {
        const long L = (long)i * G + c; if (L >= nwg) return false;
        int wgid = (int)L; { const int q = nwg / NXCD, r = nwg % NXCD, xcd = wgid % NXCD, off = wgid / NXCD; wgid = (xcd < r ? xcd * (q + 1) : r * (q + 1) + (xcd - r) * q) + off; }
        const int nig = WGM * nN, gid = wgid / nig, fm = gid * WGM, gsz = (nM - fm) < WGM ? (nM - fm) : WGM;
        u.pm = fm + ((wgid % nig) % gsz); u.pn = (wgid % nig) / gsz; return true;
    }
    __device__ __forceinline__ void a_ready(const Unit&) const {}
    __device__ __forceinline__ void done(const Unit&) const {}
};

__device__ __forceinline__ unsigned cvt_pk_bf16(float lo, float hi) { unsigned r; asm volatile("v_cvt_pk_bf16_f32 %0, %1, %2" : "=v"(r) : "v"(lo), "v"(hi)); return r; }
typedef float f32x2 __attribute__((ext_vector_type(2)));
__device__ __forceinline__ f32x2 gelu_pk(f32x2 v) {
    const f32x2 av = __builtin_elementwise_abs(v), d = av * 0.2316418882f + 1.0f;
    f32x2 t; t.x = __builtin_amdgcn_rcpf(d.x); t.y = __builtin_amdgcn_rcpf(d.y);
    f32x2 q = t * 0.5307027145f + (-0.7265760135f); q = q * t + 0.7107068705f; q = q * t + (-0.142248368f); q = q * t + 0.127414796f; q = q * t;
    const f32x2 s = (v * v) * (-0.72134752044f);
    f32x2 e; e.x = __builtin_amdgcn_exp2f(s.x); e.y = __builtin_amdgcn_exp2f(s.y);
    const f32x2 m = v * (q * e), r = v - m;
    f32x2 o; o.x = v.x < 0.f ? m.x : r.x; o.y = v.y < 0.f ? m.y : r.y; return o;
}

template <int ACT  > struct EpiBf16 {
    static constexpr bool PERM = true, AFTER_DRAIN = false; static_assert(ACT == 0 || ACT == 1, "EpiBf16: ACT is 0 (none) or 1 (gelu_pk)");
    bf16_t* O; int ldc; const float* bias; int split_cols; size_t split_stride; float scale0;
    __device__ __forceinline__ void operator()(const f32x4 (&acc)[2][2][4][2], const Unit& u, int wr, int wc, int fr, int fq) const {
        const int row0 = u.pm * BM + wr * 64 + fr; int colt = u.pn * BM; bf16_t* base = O;
        float sc = 1.f; if (split_cols) { const int t = colt / split_cols; base += (size_t)t * split_stride; colt -= t * split_cols; if (t == 0) sc = scale0; }
        const int col0 = colt + wc * 32 + 8 * fq, bcol0 = u.pn * BM + wc * 32 + 8 * fq;
        f32x4 bv[2][2];
#pragma unroll
        for (int bj = 0; bj < 2; ++bj)
#pragma unroll
            for (int n = 0; n < 2; ++n) bv[bj][n] = bias ? *(const f32x4*)(bias + bcol0 + bj * HALF + 4 * n) : (f32x4){0.f, 0.f, 0.f, 0.f};
#pragma unroll
        for (int ai = 0; ai < 2; ++ai)
#pragma unroll
            for (int m = 0; m < 4; ++m) { bf16_t* rowp = base + (size_t)(row0 + ai * HALF + m * 16) * ldc + col0;
#pragma unroll
                for (int bj = 0; bj < 2; ++bj) { f32x4 v0 = acc[ai][bj][m][0] + bv[bj][0], v1 = acc[ai][bj][m][1] + bv[bj][1];
                    if (ACT == 1) { f32x2 a = gelu_pk((f32x2){v0[0], v0[1]}), b = gelu_pk((f32x2){v0[2], v0[3]}), c = gelu_pk((f32x2){v1[0], v1[1]}), d = gelu_pk((f32x2){v1[2], v1[3]});
                        v0 = (f32x4){a.x, a.y, b.x, b.y}; v1 = (f32x4){c.x, c.y, d.x, d.y}; }
                    v0 = v0 * sc; v1 = v1 * sc; u32x4 w; w.x = cvt_pk_bf16(v0[0], v0[1]); w.y = cvt_pk_bf16(v0[2], v0[3]); w.z = cvt_pk_bf16(v1[0], v1[1]); w.w = cvt_pk_bf16(v1[2], v1[3]);
                    *(u32x4*)(rowp + bj * HALF) = w; } }
    }
};
template <class Epi, class Sched, bool ALIGN_EPI = false, bool SP2 = false>
__device__ __forceinline__ void gemm_phase(PG8_LAS unsigned char* lds, const Gemm g, const Sched& S, const Epi& E) {
    int tid_ = threadIdx.x; asm volatile("" : "+v"(tid_)); const int tid = tid_, wid = __builtin_amdgcn_readfirstlane(tid >> 6), lane = tid & 63, wr = wid >> 2, wc = wid & 3, fr = lane & 15, fq = lane >> 4;
    const int K = g.K, nt = K / BK;
    unsigned voffA[2], voffB[2];
#pragma unroll
    for (int i = 0; i < 2; ++i) { int R, C; stage_rc(tid * 16 + i * 8192, R, C); const int Rb = Epi::PERM ? ((R & ~31) + perm32(R & 31)) : R;
        voffA[i] = (unsigned)(R * K + C) * 2u; voffB[i] = (unsigned)(Rb * K + C) * 2u; }
    const size_t kstep = (size_t)(BK * 2);
    const size_t hstep = (size_t)HALF * K * 2;
    const size_t tstep = 2 * hstep;
    const unsigned ldsw = (unsigned)wid * 1024u;
    const int aoff = lds_byte(wr * 64 + fr, fq * 8), boff = lds_byte(wc * 32 + fr, fq * 8);
#define PG8_SA(b, h) (((b) * 2 + (h)) * HTB)
#define PG8_SB(b, h) ((4 + (b) * 2 + (h)) * HTB)
#define PG8_STAGE(bufoff, gbase, voff) do { _Pragma("unroll") for (int _i = 0; _i < 2; ++_i) \
        __builtin_amdgcn_global_load_lds((const unsigned*)((const char*)(gbase) + (voff)[_i]), (PG8_LAS unsigned*)(lds + (bufoff) + ldsw + _i * 8192), 16, 0, 0); } while (0)
#define PG8_LDA(dst, b, h) do { _Pragma("unroll") for (int m = 0; m < 4; ++m) _Pragma("unroll") for (int k = 0; k < 2; ++k) dst[m][k] = *(const PG8_LAS bf16x8*)(lds + PG8_SA(b, h) + aoff + m * 2048 + k * 1024); } while (0)
#define PG8_LDB(dst, b, h) do { _Pragma("unroll") for (int n = 0; n < 2; ++n) _Pragma("unroll") for (int k = 0; k < 2; ++k) dst[n][k] = *(const PG8_LAS bf16x8*)(lds + PG8_SB(b, h) + boff + n * 2048 + k * 1024); } while (0)
#define PG8_MMA(ai, bj, At, Bt) do { __builtin_amdgcn_s_setprio(1); _Pragma("unroll") for (int m = 0; m < 4; ++m) _Pragma("unroll") for (int n = 0; n < 2; ++n) _Pragma("unroll") for (int k = 0; k < 2; ++k) \
        acc[ai][bj][m][n] = __builtin_amdgcn_mfma_f32_16x16x32_bf16(Bt[n][k], At[m][k], acc[ai][bj][m][n], 0, 0, 0); __builtin_amdgcn_s_setprio(0); } while (0)
#define PG8_WAIT_V(n) asm volatile("s_waitcnt vmcnt(" #n ")" ::: "memory")
#define PG8_WAIT_L(n) asm volatile("s_waitcnt lgkmcnt(" #n ")" ::: "memory")
#define PG8_BAR __builtin_amdgcn_s_barrier()
#define PG8_SCHED __builtin_amdgcn_sched_barrier(0)
    Unit cur, nxt; int ui = 0;
    if (!S.next(0, cur)) return;
    f32x4 acc[2][2][4][2];
#pragma unroll
    for (int a = 0; a < 2; ++a)
#pragma unroll
        for (int b = 0; b < 2; ++b)
#pragma unroll
            for (int m = 0; m < 4; ++m)
#pragma unroll
                for (int n = 0; n < 2; ++n) acc[a][b][m][n] = (f32x4){0.f, 0.f, 0.f, 0.f};
    bf16x8 At[4][2], B0[2][2], B1[2][2];
    const char* cA = (const char*)g.A + (size_t)cur.pm * tstep; const char* cB = (const char*)g.Bt + (size_t)cur.pn * tstep;
    S.a_ready(cur);
    if constexpr (SP2) {
        PG8_STAGE(PG8_SB(0, 0), cB, voffB); PG8_STAGE(PG8_SB(0, 1), cB + hstep, voffB); PG8_STAGE(PG8_SA(0, 0), cA, voffA); PG8_STAGE(PG8_SA(0, 1), cA + hstep, voffA);
        if (wr == 1) PG8_BAR;
        PG8_WAIT_V(2); PG8_BAR;
        PG8_STAGE(PG8_SB(1, 0), cB + kstep, voffB); PG8_STAGE(PG8_SA(1, 0), cA + kstep, voffA); PG8_STAGE(PG8_SB(1, 1), cB + hstep + kstep, voffB);
        PG8_WAIT_V(6); PG8_BAR;
    } else {
        PG8_STAGE(PG8_SB(0, 0), cB, voffB); PG8_STAGE(PG8_SA(0, 0), cA, voffA); PG8_STAGE(PG8_SB(0, 1), cB + hstep, voffB); PG8_STAGE(PG8_SA(0, 1), cA + hstep, voffA);
        if (wr == 1) PG8_BAR;
        PG8_WAIT_V(4); PG8_BAR;
        PG8_STAGE(PG8_SB(1, 0), cB + kstep, voffB); PG8_STAGE(PG8_SA(1, 0), cA + kstep, voffA); PG8_STAGE(PG8_SB(1, 1), cB + hstep + kstep, voffB);
        PG8_WAIT_V(6); PG8_BAR;
    }
    for (;;) {
        const bool has_next = S.next(ui + 1, nxt);
        const char* nA = has_next ? (const char*)g.A + (size_t)nxt.pm * tstep : cA; const char* nB = has_next ? (const char*)g.Bt + (size_t)nxt.pn * tstep : cB;
        for (int t = 0; t < nt; t += 2) {
            const bool last = (t == nt - 2);
            const char* a1 = cA + (size_t)(t + 1) * kstep;
            const char* a2 = last ? nA : cA + (size_t)(t + 2) * kstep; const char* b2 = last ? nB : cB + (size_t)(t + 2) * kstep;
            const char* a3 = a2 + kstep; const char* b3 = b2 + kstep;
            if (last && has_next) S.a_ready(nxt);
            if constexpr (SP2) {
            PG8_LDB(B0, 0, 0); PG8_LDB(B1, 0, 1); PG8_SCHED; PG8_LDA(At, 0, 0); PG8_STAGE(PG8_SA(1, 1), a1 + hstep, voffA);
            PG8_WAIT_V(8); PG8_WAIT_L(0); PG8_BAR; PG8_MMA(0, 0, At, B0); PG8_MMA(0, 1, At, B1); PG8_BAR; PG8_SCHED;
            PG8_LDA(At, 0, 1); PG8_STAGE(PG8_SB(0, 0), b2, voffB); PG8_STAGE(PG8_SB(0, 1), b2 + hstep, voffB); PG8_STAGE(PG8_SA(0, 0), a2, voffA);
            PG8_WAIT_V(8); PG8_WAIT_L(0); PG8_BAR; PG8_MMA(1, 0, At, B0); PG8_MMA(1, 1, At, B1); PG8_BAR; PG8_SCHED;
            PG8_LDB(B0, 1, 0); PG8_LDB(B1, 1, 1); PG8_SCHED; PG8_LDA(At, 1, 0); PG8_STAGE(PG8_SA(0, 1), a2 + hstep, voffA);
            PG8_WAIT_V(8); PG8_WAIT_L(0); PG8_BAR; PG8_MMA(0, 0, At, B0); PG8_MMA(0, 1, At, B1); PG8_BAR; PG8_SCHED;
            PG8_LDA(At, 1, 1); PG8_STAGE(PG8_SB(1, 0), b3, voffB); PG8_STAGE(PG8_SB(1, 1), b3 + hstep, voffB); PG8_STAGE(PG8_SA(1, 0), a3, voffA);
            PG8_WAIT_V(8); PG8_WAIT_L(0); PG8_BAR; PG8_MMA(1, 0, At, B0); PG8_MMA(1, 1, At, B1); PG8_BAR; PG8_SCHED;
            } else {
            PG8_LDB(B0, 0, 0); PG8_SCHED; PG8_LDA(At, 0, 0); PG8_STAGE(PG8_SA(1, 1), a1 + hstep, voffA);
            PG8_WAIT_L(8); PG8_BAR; PG8_WAIT_L(0); PG8_MMA(0, 0, At, B0); PG8_BAR; PG8_SCHED;
            PG8_LDB(B1, 0, 1); PG8_STAGE(PG8_SB(0, 0), b2, voffB);
            PG8_BAR; PG8_WAIT_L(0); PG8_MMA(0, 1, At, B1); PG8_BAR;
            PG8_LDA(At, 0, 1); PG8_STAGE(PG8_SA(0, 0), a2, voffA);
            PG8_BAR; PG8_WAIT_L(0); PG8_MMA(1, 0, At, B0); PG8_BAR; PG8_SCHED;
            PG8_STAGE(PG8_SB(0, 1), b2 + hstep, voffB);
            PG8_WAIT_V(6); PG8_BAR; PG8_MMA(1, 1, At, B1); PG8_BAR;
            PG8_LDB(B0, 1, 0); PG8_SCHED; PG8_LDA(At, 1, 0); PG8_STAGE(PG8_SA(0, 1), a2 + hstep, voffA);
            PG8_WAIT_L(8); PG8_BAR; PG8_WAIT_L(0); PG8_MMA(0, 0, At, B0); PG8_BAR; PG8_SCHED;
            PG8_LDB(B1, 1, 1); PG8_STAGE(PG8_SB(1, 0), b3, voffB);
            PG8_BAR; PG8_WAIT_L(0); PG8_MMA(0, 1, At, B1); PG8_BAR;
            PG8_LDA(At, 1, 1); PG8_STAGE(PG8_SA(1, 0), a3, voffA);
            PG8_BAR; PG8_WAIT_L(0); PG8_MMA(1, 0, At, B0); PG8_BAR; PG8_SCHED;
            PG8_STAGE(PG8_SB(1, 1), b3 + hstep, voffB);
            PG8_WAIT_V(6); PG8_BAR; PG8_MMA(1, 1, At, B1); PG8_BAR;
            }
        }
        if constexpr (ALIGN_EPI) { if (wr == 0) PG8_BAR; }
        if constexpr (!Epi::AFTER_DRAIN) { E(acc, cur, wr, wc, fr, fq); S.done(cur); }
        if (!has_next) break;
#pragma unroll
        for (int a = 0; a < 2; ++a)
#pragma unroll
            for (int b = 0; b < 2; ++b)
#pragma unroll
                for (int m = 0; m < 4; ++m)
#pragma unroll
                    for (int n = 0; n < 2; ++n) acc[a][b][m][n] = (f32x4){0.f, 0.f, 0.f, 0.f};
        cur = nxt; cA = nA; cB = nB; ++ui;
        if constexpr (ALIGN_EPI) { if (wr == 1) PG8_BAR; }
    }
    PG8_WAIT_V(0);
    if constexpr (!ALIGN_EPI) { if (wr == 0) PG8_BAR; }
    PG8_BAR;
    if constexpr (Epi::AFTER_DRAIN) { E.fused(acc, cur, wr, wc, fr, fq, lds, wid, lane); S.done(cur); }
#undef PG8_SA
#undef PG8_SB
#undef PG8_STAGE
#undef PG8_LDA
#undef PG8_LDB
#undef PG8_MMA
#undef PG8_WAIT_V
#undef PG8_WAIT_L
#undef PG8_BAR
#undef PG8_SCHED
}
}
namespace pg8 {
__device__ __forceinline__ float silu_f(float x) { return x * __builtin_amdgcn_rcpf(1.0f + __builtin_amdgcn_exp2f(-1.4426950408889634f * x)); }
struct EpiSplit4 {
    static constexpr bool PERM = true, AFTER_DRAIN = false;
    bf16_t* O; size_t split_stride; const float* sumsq; float qscale; int q_split, gate_split;
    __device__ __forceinline__ void operator()(const f32x4 (&acc)[2][2][4][2], const Unit& u, int wr, int wc, int fr, int fq) const {
        const int row0 = u.pm * BM + wr * 64 + fr; int colt = u.pn * BM; const int t = colt >> 10; colt &= 1023;
        bf16_t* base = O + (size_t)t * split_stride; const int col0 = colt + wc * 32 + 8 * fq;
        const float ts = (t == q_split) ? qscale : 1.f; const bool gate = (t == gate_split);
#pragma unroll
        for (int ai = 0; ai < 2; ++ai)
#pragma unroll
            for (int m = 0; m < 4; ++m) { const int row = row0 + ai * HALF + m * 16; float rs = ts;
                if (sumsq) rs *= 1.0f / sqrtf(sumsq[row] * (1.0f / 1024.0f) + 1e-6f);
                bf16_t* rowp = base + (size_t)row * 1024 + col0;
#pragma unroll
                for (int bj = 0; bj < 2; ++bj) { f32x4 v0 = acc[ai][bj][m][0] * rs, v1 = acc[ai][bj][m][1] * rs;
                    if (gate) { v0 = (f32x4){silu_f(v0[0]), silu_f(v0[1]), silu_f(v0[2]), silu_f(v0[3])}; v1 = (f32x4){silu_f(v1[0]), silu_f(v1[1]), silu_f(v1[2]), silu_f(v1[3])}; }
                    u32x4 w; w.x = cvt_pk_bf16(v0[0], v0[1]); w.y = cvt_pk_bf16(v0[2], v0[3]); w.z = cvt_pk_bf16(v1[0], v1[1]); w.w = cvt_pk_bf16(v1[2], v1[3]);
                    *(u32x4*)(rowp + bj * HALF) = w; } }
    }
};
struct EpiRes {
    static constexpr bool PERM = true, AFTER_DRAIN = false;
    const float* base; float* out; bf16_t* xa; float* sumsq;
    __device__ __forceinline__ void load_batch(f32x4 (&b)[2][2][2], int q, int row0, int col0) const {
#pragma unroll
        for (int mm = 0; mm < 2; ++mm)
#pragma unroll
            for (int bj = 0; bj < 2; ++bj) { const size_t off = (size_t)(row0 + (q >> 1) * HALF + (2 * (q & 1) + mm) * 16) * 1024 + col0 + bj * HALF; b[mm][bj][0] = *(const f32x4*)(base + off); b[mm][bj][1] = *(const f32x4*)(base + off + 4); }
    }
    __device__ __forceinline__ void store_batch(const f32x4 (&b)[2][2][2], const f32x4 (&acc)[2][2][4][2], int q, int row0, int col0, int fq, int pslot) const {
#pragma unroll
        for (int mm = 0; mm < 2; ++mm) { const int ai = q >> 1, m = 2 * (q & 1) + mm; const int row = row0 + ai * HALF + m * 16; const size_t off = (size_t)row * 1024 + col0; float ss = 0.f;
#pragma unroll
            for (int bj = 0; bj < 2; ++bj) { const f32x4 v0 = b[mm][bj][0] + acc[ai][bj][m][0], v1 = b[mm][bj][1] + acc[ai][bj][m][1];
                if (out) { *(f32x4*)(out + off + bj * HALF) = v0; *(f32x4*)(out + off + bj * HALF + 4) = v1; }
                ss += (v0[0] * v0[0] + v0[1] * v0[1]) + (v0[2] * v0[2] + v0[3] * v0[3]) + (v1[0] * v1[0] + v1[1] * v1[1]) + (v1[2] * v1[2] + v1[3] * v1[3]);
                if (xa) { u32x4 w; w.x = cvt_pk_bf16(v0[0], v0[1]); w.y = cvt_pk_bf16(v0[2], v0[3]); w.z = cvt_pk_bf16(v1[0], v1[1]); w.w = cvt_pk_bf16(v1[2], v1[3]);
                    *(u32x4*)(xa + off + bj * HALF) = w; } }
            if (sumsq) { ss += __shfl_xor(ss, 16); ss += __shfl_xor(ss, 32); if (fq == 0) atomicAdd(sumsq + row, ss); } }
    }
    __device__ __forceinline__ void operator()(const f32x4 (&acc)[2][2][4][2], const Unit& u, int wr, int wc, int fr, int fq) const {
        const int row0 = u.pm * BM + wr * 64 + fr; const int col0 = u.pn * BM + wc * 32 + 8 * fq; const int pslot = u.pn * 4 + wc;
        f32x4 b0[2][2][2], b1[2][2][2];
        load_batch(b0, 0, row0, col0);
        load_batch(b1, 1, row0, col0); store_batch(b0, acc, 0, row0, col0, fq, pslot);
        load_batch(b0, 2, row0, col0); store_batch(b1, acc, 1, row0, col0, fq, pslot);
        load_batch(b1, 3, row0, col0); store_batch(b0, acc, 2, row0, col0, fq, pslot);
        store_batch(b1, acc, 3, row0, col0, fq, pslot);
    }
};

struct EpiResBf {
    static constexpr bool PERM = true, AFTER_DRAIN = false;
    const bf16_t* resid; float* out;
    __device__ __forceinline__ void operator()(const f32x4 (&acc)[2][2][4][2], const Unit& u, int wr, int wc, int fr, int fq) const {
        const int row0 = u.pm * BM + wr * 64 + fr; const int col0 = u.pn * BM + wc * 32 + 8 * fq;
        u32x4 r[2][4][2];
#pragma unroll
        for (int ai = 0; ai < 2; ++ai)
#pragma unroll
            for (int m = 0; m < 4; ++m)
#pragma unroll
                for (int bj = 0; bj < 2; ++bj) r[ai][m][bj] = *(const u32x4*)(resid + (size_t)(row0 + ai * HALF + m * 16) * 1024 + col0 + bj * HALF);
#pragma unroll
        for (int ai = 0; ai < 2; ++ai)
#pragma unroll
            for (int m = 0; m < 4; ++m) { const size_t off = (size_t)(row0 + ai * HALF + m * 16) * 1024 + col0;
#pragma unroll
                for (int bj = 0; bj < 2; ++bj) { const u32x4 w = r[ai][m][bj];
                    const f32x4 b0 = {__uint_as_float(w.x << 16), __uint_as_float(w.x & 0xffff0000u), __uint_as_float(w.y << 16), __uint_as_float(w.y & 0xffff0000u)};
                    const f32x4 b1 = {__uint_as_float(w.z << 16), __uint_as_float(w.z & 0xffff0000u), __uint_as_float(w.w << 16), __uint_as_float(w.w & 0xffff0000u)};
                    *(f32x4*)(out + off + bj * HALF) = acc[ai][bj][m][0] + b0; *(f32x4*)(out + off + bj * HALF + 4) = acc[ai][bj][m][1] + b1; } }
    }
};

struct EpiB {
    static constexpr bool PERM = true, AFTER_DRAIN = false;
    bf16_t* O; size_t split_stride; const float* sumsq; const float* kg; const float* qg; const float* rope; float qs;
    __device__ __forceinline__ void operator()(const f32x4 (&acc)[2][2][4][2], const Unit& u, int wr, int wc, int fr, int fq) const {
        const int row0 = u.pm * BM + wr * 64 + fr; int colt = u.pn * BM; const int t = colt >> 10; colt &= 1023;
        bf16_t* base = O + (size_t)t * split_stride;
        float rsv[2][4];
#pragma unroll
        for (int ai = 0; ai < 2; ++ai)
#pragma unroll
            for (int m = 0; m < 4; ++m) rsv[ai][m] = __builtin_amdgcn_rsqf(sumsq[row0 + ai * HALF + m * 16] * (1.0f / 1024.0f) + 1e-6f);
        if (t & 1) {
            const int col0 = colt + wc * 32 + 8 * fq; const bool gate = (t == 3);
#pragma unroll
            for (int ai = 0; ai < 2; ++ai)
#pragma unroll
                for (int m = 0; m < 4; ++m) { const int row = row0 + ai * HALF + m * 16; const float rs = rsv[ai][m];
                    bf16_t* rowp = base + (size_t)row * 1024 + col0;
#pragma unroll
                    for (int bj = 0; bj < 2; ++bj) { f32x4 v0 = acc[ai][bj][m][0] * rs, v1 = acc[ai][bj][m][1] * rs;
                        if (gate) { v0 = (f32x4){silu_f(v0[0]), silu_f(v0[1]), silu_f(v0[2]), silu_f(v0[3])}; v1 = (f32x4){silu_f(v1[0]), silu_f(v1[1]), silu_f(v1[2]), silu_f(v1[3])}; }
                        u32x4 w; w.x = cvt_pk_bf16(v0[0], v0[1]); w.y = cvt_pk_bf16(v0[2], v0[3]); w.z = cvt_pk_bf16(v1[0], v1[1]); w.w = cvt_pk_bf16(v1[2], v1[3]);
                        *(u32x4*)(rowp + bj * HALF) = w; } }
        } else {
            const float* g = (t == 0) ? kg : qg; const float sc = (t == 2) ? qs : 1.0f;
            f32x4 g1[2], g2[2];
#pragma unroll
            for (int n = 0; n < 2; ++n) { g1[n] = *(const f32x4*)(g + 8 * fq + 4 * n) * sc; g2[n] = *(const f32x4*)(g + 32 + 8 * fq + 4 * n) * sc; }
            const int colc = colt + wc * 64 + 8 * fq;
#pragma unroll
            for (int aim = 0; aim < 4; ++aim) { const int ai = aim >> 1, m0 = 2 * (aim & 1);
                f32x4 cs[4][4];
#pragma unroll
                for (int m = m0; m < m0 + 2; ++m) { const f32x4* rp = (const f32x4*)(rope + ((size_t)(row0 + ai * HALF + m * 16) * 32 + 8 * fq) * 2); cs[m][0] = rp[0]; cs[m][1] = rp[1]; cs[m][2] = rp[2]; cs[m][3] = rp[3]; }
#pragma unroll
                for (int m = m0; m < m0 + 2; ++m) { const int row = row0 + ai * HALF + m * 16; const float rs = rsv[ai][m];
                    f32x4 a1[2], a2[2]; float ss = 0.f;
#pragma unroll
                    for (int n = 0; n < 2; ++n) { a1[n] = acc[ai][0][m][n] * rs; a2[n] = acc[ai][1][m][n] * rs;
                        ss += (a1[n][0] * a1[n][0] + a1[n][1] * a1[n][1]) + (a1[n][2] * a1[n][2] + a1[n][3] * a1[n][3]) + (a2[n][0] * a2[n][0] + a2[n][1] * a2[n][1]) + (a2[n][2] * a2[n][2] + a2[n][3] * a2[n][3]); }
                    ss += __shfl_xor(ss, 16); ss += __shfl_xor(ss, 32);
                    const float cr = __builtin_amdgcn_rsqf(ss * (1.0f / 64.0f) + 1e-6f);
                    f32x4 o1[2], o2[2];
#pragma unroll
                    for (int n = 0; n < 2; ++n) { const f32x4 t1 = a1[n] * cr * g1[n], t2 = a2[n] * cr * g2[n]; const f32x4 c0 = cs[m][2 * n], c1 = cs[m][2 * n + 1];
                        o1[n] = (f32x4){t1[0] * c0[0] - t2[0] * c0[1], t1[1] * c0[2] - t2[1] * c0[3], t1[2] * c1[0] - t2[2] * c1[1], t1[3] * c1[2] - t2[3] * c1[3]};
                        o2[n] = (f32x4){t2[0] * c0[0] + t1[0] * c0[1], t2[1] * c0[2] + t1[1] * c0[3], t2[2] * c1[0] + t1[2] * c1[1], t2[3] * c1[2] + t1[3] * c1[3]}; }
                    bf16_t* rowp = base + (size_t)row * 1024 + colc; u32x4 w;
                    w.x = cvt_pk_bf16(o1[0][0], o1[0][1]); w.y = cvt_pk_bf16(o1[0][2], o1[0][3]); w.z = cvt_pk_bf16(o1[1][0], o1[1][1]); w.w = cvt_pk_bf16(o1[1][2], o1[1][3]); *(u32x4*)(rowp) = w;
                    w.x = cvt_pk_bf16(o2[0][0], o2[0][1]); w.y = cvt_pk_bf16(o2[0][2], o2[0][3]); w.z = cvt_pk_bf16(o2[1][0], o2[1][1]); w.w = cvt_pk_bf16(o2[1][2], o2[1][3]); *(u32x4*)(rowp + 32) = w; }
            }
        }
    }
};
}
namespace mk {
#define LAS __attribute__((address_space(3)))
typedef unsigned short bf16;
typedef unsigned u32x4 __attribute__((ext_vector_type(4)));
typedef float f32x4 __attribute__((ext_vector_type(4)));
typedef float f32x16 __attribute__((ext_vector_type(16)));
typedef short bf16x8 __attribute__((ext_vector_type(8)));
typedef short s16x4 __attribute__((ext_vector_type(4)));
typedef short v4i16_t __attribute__((ext_vector_type(4)));
typedef float f32x2 __attribute__((ext_vector_type(2)));

constexpr int BATCH = 2, SEQ = 8192, DM = 1024, M = BATCH * SEQ, NWAVES = 8, NTHR = 512;
constexpr float EPS = 1e-6f, LOG2E = 1.4426950408889634f, QS = 0.125f * LOG2E;
constexpr float SB_MASS = 2.3283064365386963e-10f;
constexpr size_t MiB = 1u << 20;
constexpr size_t WS_SUMSQ = 0;
constexpr size_t WS_BAR = 256 * 1024;
constexpr size_t WS_ROPE = 1 * MiB;
constexpr size_t WS_WINA = 5 * MiB;
constexpr size_t WS_WOUTA = 13 * MiB;
constexpr size_t WS_WB = 15 * MiB;
constexpr size_t WS_WOUTB = 23 * MiB;
constexpr size_t WS_XA = 32 * MiB;
constexpr size_t WS_T = 64 * MiB;
constexpr size_t WS_O = 192 * MiB;
constexpr size_t WS_END = 224 * MiB;
constexpr size_t TSTRIDE = (size_t)M * DM;
constexpr int RING_BYTES = 131072, LDS_BYTES = 143360;
constexpr int DIFF_WSF = 137216, LDS_CTL = 141312;
constexpr int ATT_WSF = 98304, ATT_FLAGS = 98304 + 2048;

__device__ __forceinline__ int crow(int r, int hi) { return (r & 3) + 8 * (r >> 2) + 4 * hi; }
__device__ __forceinline__ unsigned cvtpk(float lo, float hi) { typedef __bf16 b2 __attribute__((ext_vector_type(2))); f32x2 v = {lo, hi}; b2 b = __builtin_convertvector(v, b2); return __builtin_bit_cast(unsigned, b); }
__device__ __forceinline__ float bf2f(unsigned short b) { return __uint_as_float((unsigned)b << 16); }
__device__ __forceinline__ s16x4 vtr(const LAS unsigned char* p) { return __builtin_bit_cast(s16x4, __builtin_amdgcn_ds_read_tr16_b64_v4i16((LAS v4i16_t*)p)); }
__device__ __forceinline__ float wave_sum(float v) {
#pragma unroll
    for (int o = 1; o < 64; o <<= 1) v += __shfl_xor(v, o);
    return v;
}
__device__ __forceinline__ float wave_max(float v) {
#pragma unroll
    for (int o = 1; o < 64; o <<= 1) v = fmaxf(v, __shfl_xor(v, o));
    return v;
}
#define MFMA32(a, b, c) __builtin_amdgcn_mfma_f32_32x32x16_bf16(a, b, c, 0, 0, 0)

struct KVMap { int kg0, kg1, vg0, vg1, kl0, kl1, vl0, vl1; };
struct KVStage { u32x4 k0, k1, v0, v1; };
__device__ __forceinline__ KVMap kv_map(int w, int lane) {
    KVMap m; const int krow = 16 * (w >> 1) + (lane >> 2); const int kc0 = 8 * (w & 1) + (lane & 3), kc1 = kc0 + 4;
    m.kg0 = krow * DM + 8 * kc0; m.kg1 = krow * DM + 8 * kc1;
    m.kl0 = (kc0 >> 3) * 8448 + (kc0 & 7) * 1056 + krow * 16; m.kl1 = (kc1 >> 3) * 8448 + (kc1 & 7) * 1056 + krow * 16;
    const int vr0 = 8 * w + (lane >> 4), vr1 = vr0 + 4, vch = lane & 15;
    m.vg0 = vr0 * DM + 8 * vch; m.vg1 = vr1 * DM + 8 * vch;
    m.vl0 = 17408 + (vch >> 2) * 4160 + vr0 * 64 + (vch & 3) * 16; m.vl1 = 17408 + (vch >> 2) * 4160 + vr1 * 64 + (vch & 3) * 16;
    return m;
}
__device__ __forceinline__ void kv_gload(KVStage& s, const bf16* Kt, const bf16* Vt, const KVMap& m) {
    s.k0 = *(const u32x4*)(Kt + m.kg0); s.k1 = *(const u32x4*)(Kt + m.kg1); s.v0 = *(const u32x4*)(Vt + m.vg0); s.v1 = *(const u32x4*)(Vt + m.vg1);
}
__device__ __forceinline__ void kv_lstore(const KVStage& s, LAS unsigned char* buf, const KVMap& m) {
    *(LAS u32x4*)(buf + m.kl0) = s.k0; *(LAS u32x4*)(buf + m.kl1) = s.k1; *(LAS u32x4*)(buf + m.vl0) = s.v0; *(LAS u32x4*)(buf + m.vl1) = s.v1;
}
__device__ __forceinline__ void qk_tile(f32x16& p0, f32x16& p1, const LAS unsigned char* kb, const bf16x8 (&qr)[4], float init) {
#pragma unroll
    for (int r = 0; r < 16; ++r) { p0[r] = init; p1[r] = init; }
    constexpr int RD = 3;
    bf16x8 kf[8];
#define KADDR(i) (kb + ((i) >> 1) * 2112 + ((i) & 1) * 512)
#pragma unroll
    for (int i = 0; i < RD; ++i) kf[i] = *(const LAS bf16x8*)KADDR(i);
    __builtin_amdgcn_sched_barrier(0);
#pragma unroll
    for (int i = 0; i < 8; ++i) {
        if (i + RD < 8) kf[i + RD] = *(const LAS bf16x8*)KADDR(i + RD);
        if (i & 1) p1 = MFMA32(kf[i], qr[i >> 1], p1); else p0 = MFMA32(kf[i], qr[i >> 1], p0);
        __builtin_amdgcn_sched_barrier(0);
    }
#undef KADDR
}
template <int NDB> __device__ __forceinline__ void pv_tile(f32x16 (&o)[NDB], const LAS unsigned char* vb, const f32x16& p0, const f32x16& p1) {
    bf16x8 pa[4];
    { u32x4 w;
      w = (u32x4){cvtpk(p0[0], p0[1]), cvtpk(p0[2], p0[3]), cvtpk(p0[4], p0[5]), cvtpk(p0[6], p0[7])}; pa[0] = __builtin_bit_cast(bf16x8, w);
      w = (u32x4){cvtpk(p0[8], p0[9]), cvtpk(p0[10], p0[11]), cvtpk(p0[12], p0[13]), cvtpk(p0[14], p0[15])}; pa[1] = __builtin_bit_cast(bf16x8, w);
      w = (u32x4){cvtpk(p1[0], p1[1]), cvtpk(p1[2], p1[3]), cvtpk(p1[4], p1[5]), cvtpk(p1[6], p1[7])}; pa[2] = __builtin_bit_cast(bf16x8, w);
      w = (u32x4){cvtpk(p1[8], p1[9]), cvtpk(p1[10], p1[11]), cvtpk(p1[12], p1[13]), cvtpk(p1[14], p1[15])}; pa[3] = __builtin_bit_cast(bf16x8, w); }
    constexpr int N = 4 * NDB, RD = 3;
    s16x4 lo[N], hi[N];
#define VADDR(i) (vb + ((i) % NDB) * 4160 + ((i) / NDB) * 1024)
#pragma unroll
    for (int i = 0; i < RD; ++i) { lo[i] = vtr(VADDR(i)); hi[i] = vtr(VADDR(i) + 512); }
    __builtin_amdgcn_sched_barrier(0);
#pragma unroll
    for (int i = 0; i < N; ++i) {
        if (i + RD < N) { lo[i + RD] = vtr(VADDR(i + RD)); hi[i + RD] = vtr(VADDR(i + RD) + 512); }
        const bf16x8 vf = {lo[i][0], lo[i][1], lo[i][2], lo[i][3], hi[i][0], hi[i][1], hi[i][2], hi[i][3]};
        o[i % NDB] = MFMA32(pa[i / NDB], vf, o[i % NDB]);
        __builtin_amdgcn_sched_barrier(0);
    }
#undef VADDR
}
template <int MODE> __device__ __forceinline__ void row_pass(const LAS float* E, int tid, size_t grow0, int col0, const bf16* G, bf16* O, const float* subg, float post) {
    const int row = tid >> 2, seg = tid & 3; const LAS float* e = E + row * 132 + 32 * seg;
    float v[32];
#pragma unroll
    for (int i = 0; i < 8; ++i) { const f32x4 x = *(const LAS f32x4*)(e + 4 * i); v[4 * i] = x[0]; v[4 * i + 1] = x[1]; v[4 * i + 2] = x[2]; v[4 * i + 3] = x[3]; }
    if (MODE == 1) { float ss = 0.f;
#pragma unroll
        for (int i = 0; i < 32; ++i) ss += v[i] * v[i];
        ss += __shfl_xor(ss, 1); ss += __shfl_xor(ss, 2);
        const float rstd = post / sqrtf(ss * (1.0f / 128.0f) + EPS);
#pragma unroll
        for (int i = 0; i < 8; ++i) { const f32x4 g = *(const f32x4*)(subg + 32 * seg + 4 * i); v[4 * i] *= rstd * g[0]; v[4 * i + 1] *= rstd * g[1]; v[4 * i + 2] *= rstd * g[2]; v[4 * i + 3] *= rstd * g[3]; } }
    const size_t off = (grow0 + row) * DM + col0 + 32 * seg;
#pragma unroll
    for (int i = 0; i < 4; ++i) { const u32x4 g = *(const u32x4*)(G + off + 8 * i); u32x4 w;
#pragma unroll
        for (int j = 0; j < 4; ++j) { const float lo = v[8 * i + 2 * j] * __uint_as_float(g[j] << 16), hi = v[8 * i + 2 * j + 1] * __uint_as_float(g[j] & 0xffff0000u); w[j] = cvtpk(lo, hi); }
        *(u32x4*)(O + off + 8 * i) = w; }
}

#define XB_TMO      128
#define XB_XCNT(j)  (256  + 64 * (j))
#define XB_XSUB(j)  (1280 + 64 * (j))
#define XB_XGEN(j)  (2304 + 64 * (j))
#define XB_TOP      3328
#define XB_TOPGEN   3392
#define XCD_BAR_WORDS 3456
#define XB_SPIN_CAP (1u << 18)

__device__ __forceinline__ unsigned xb_ld(unsigned* p)              { return __hip_atomic_load(p, __ATOMIC_RELAXED, __HIP_MEMORY_SCOPE_AGENT); }
__device__ __forceinline__ unsigned xb_add(unsigned* p, unsigned v) { return __hip_atomic_fetch_add(p, v, __ATOMIC_RELAXED, __HIP_MEMORY_SCOPE_AGENT); }
__device__ __forceinline__ unsigned xb_xcc_id() { return (unsigned)__builtin_amdgcn_s_getreg((3 << 11) | 20) & 0xFu; }
#define XB_SPIN(cond, bar) do { unsigned _sp = 0; while (cond) { __builtin_amdgcn_s_sleep(1); \
    if ((++_sp & 255u) == 0u) { if (xb_ld(&(bar)[XB_TMO])) break; if (_sp > XB_SPIN_CAP) { atomicAdd(&(bar)[XB_TMO], 1u); break; } } } } while (0)

struct XcdBarrier {
    unsigned* bar; unsigned x;
    volatile LAS unsigned* st;
};

__device__ __forceinline__ XcdBarrier xcd_barrier_post(unsigned* bar, volatile LAS unsigned* st) {
    XcdBarrier b; b.bar = bar; b.x = xb_xcc_id(); b.st = st;
    if (threadIdx.x == 0) (void)xb_add(&bar[XB_XCNT(b.x)], 1u);
    return b;
}
__device__ __forceinline__ void xcd_barrier_complete(unsigned* bar, unsigned x, unsigned& nloc, unsigned& nx) {
    const unsigned G = gridDim.x * gridDim.y * gridDim.z;
    unsigned sum, cnt, mine, sp = 0u;
    for (;;) {
        sum = 0u; cnt = 0u; mine = 0u;
#pragma unroll
        for (unsigned j = 0; j < 16; ++j) { const unsigned c = xb_ld(&bar[XB_XCNT(j)]); sum += c; cnt += (c > 0u) ? 1u : 0u; mine = (j == x) ? c : mine; }
        if (sum == G) break;
        __builtin_amdgcn_s_sleep(1);
        if ((++sp & 255u) == 0u) { if (xb_ld(&bar[XB_TMO])) break; if (sp > XB_SPIN_CAP) { atomicAdd(&bar[XB_TMO], 1u); break; } }
    }
    nloc = mine > 0u ? mine : 1u; nx = cnt > 0u ? cnt : 1u;
}

__device__ __forceinline__ void xcd_barrier(const XcdBarrier& b) {
    asm volatile("s_waitcnt vmcnt(0)" ::: "memory");
    __syncthreads();
    if (threadIdx.x == 0) {
        unsigned* bar = b.bar;
        __builtin_amdgcn_s_waitcnt(0);
        unsigned nloc = b.st[0], nx = b.st[1];
        if (nloc == 0u) { xcd_barrier_complete(bar, b.x, nloc, nx); b.st[0] = nloc; b.st[1] = nx; }
        const unsigned old = xb_add(&bar[XB_XSUB(b.x)], 1u);
        const unsigned gen = old / nloc;
        if (old + 1u == (gen + 1u) * nloc) {
            __builtin_amdgcn_fence(__ATOMIC_RELEASE, "agent");
            asm volatile("s_waitcnt vmcnt(0)" ::: "memory");
            const unsigned og = xb_add(&bar[XB_TOP], 1u);
            const unsigned tg = og / nx;
            if (og + 1u == (tg + 1u) * nx) xb_add(&bar[XB_TOPGEN], 1u);
            else XB_SPIN(xb_ld(&bar[XB_TOPGEN]) == tg, bar);
            __builtin_amdgcn_fence(__ATOMIC_ACQUIRE, "agent");
            xb_add(&bar[XB_XGEN(b.x)], 1u);
            asm volatile("s_waitcnt vmcnt(0)" ::: "memory");
        } else {
            XB_SPIN(xb_ld(&bar[XB_XGEN(b.x)]) == gen, bar);
            __builtin_amdgcn_fence(__ATOMIC_ACQUIRE, "agent");
            asm volatile("s_waitcnt vmcnt(0)" ::: "memory");
        }
    }
    __syncthreads();
}

__device__ __forceinline__ void stick_attn_phase(LAS unsigned char* lds, int vcu, int G, const bf16* Qt, const bf16* Kt, const bf16* Vt, const bf16* Gt, bf16* Ot) {
    int tid_ = threadIdx.x; asm volatile("" : "+v"(tid_)); const int tid = tid_, lane = tid & 63, w = __builtin_amdgcn_readfirstlane(tid >> 6), r32 = lane & 31, hi = lane >> 5;
    const int c = w >> 2, jw = w & 3;
    const KVMap map = kv_map(w, lane);
    const LAS unsigned char* kfb = lds + c * 8448 + hi * 1056 + r32 * 16;
    const LAS unsigned char* vfb = lds + 17408 + (2 * c) * 4160 + (4 * hi + ((lane & 15) >> 2)) * 64 + ((lane >> 4) & 1) * 32 + (lane & 3) * 8;
    LAS float* E = (LAS float*)lds;
    volatile LAS float* flags = (volatile LAS float*)(lds + ATT_FLAGS);
    for (int u = vcu; u < 1024; u += G) {
        const int bhp = u >> 6, qb = u & 63, b = bhp >> 3, hp = bhp & 7;
        const size_t rowbase = (size_t)b * SEQ; const int q0 = qb * 128, q0w = q0 + 32 * jw, qrow = q0w + r32, col0 = hp * 128;
        const int tmax = 2 * qb + 1, tw = (q0w + 30) >> 6;
        bf16x8 qr[4];
#pragma unroll
        for (int d0 = 0; d0 < 4; ++d0) qr[d0] = *(const bf16x8*)(Qt + (rowbase + qrow) * DM + col0 + c * 64 + d0 * 16 + hi * 8);
        f32x16 o[2];
#pragma unroll
        for (int r = 0; r < 16; ++r) { o[0][r] = 0.f; o[1][r] = 0.f; }
        float crun = 1.0f; bool active = true;
        KVStage st;
        kv_gload(st, Kt + (rowbase + 64 * tmax) * DM + col0, Vt + (rowbase + 64 * tmax) * DM + col0, map);
        kv_lstore(st, lds, map);
        __builtin_amdgcn_s_waitcnt(0);
        __syncthreads();
        int it = 0;
        for (int t = tmax; t >= 0; --t, ++it) {
            const int cur = it & 1;
            if (t > 0) kv_gload(st, Kt + (rowbase + 64 * (t - 1)) * DM + col0, Vt + (rowbase + 64 * (t - 1)) * DM + col0, map);
            if (active && t <= tw) {
                f32x16 p0, p1, l0, l1;
                qk_tile(p0, p1, kfb + cur * 34048, qr, 0.f);
                const bool need_mask = (64 * t + 63 >= q0w);
                const int kv0 = 64 * t;
#pragma unroll
                for (int r = 0; r < 16; ++r) {
                    { const float z = p0[r], e = __builtin_amdgcn_exp2f(-fabsf(z)), rr = __builtin_amdgcn_rcpf(1.0f + e), er = e * rr; float nb = (z >= 0.f) ? er : rr, bb = (z >= 0.f) ? rr : er;
                      if (need_mask && (kv0 + crow(r, hi) >= qrow)) { nb = 1.f; bb = 0.f; } l0[r] = nb; p0[r] = bb; }
                    { const float z = p1[r], e = __builtin_amdgcn_exp2f(-fabsf(z)), rr = __builtin_amdgcn_rcpf(1.0f + e), er = e * rr; float nb = (z >= 0.f) ? er : rr, bb = (z >= 0.f) ? rr : er;
                      if (need_mask && (kv0 + 32 + crow(r, hi) >= qrow)) { nb = 1.f; bb = 0.f; } l1[r] = nb; p1[r] = bb; }
                }
                float S[16];
#pragma unroll
                for (int g = 0; g < 4; ++g) {
                    const float s0 = (l0[4 * g] * l0[4 * g + 1]) * (l0[4 * g + 2] * l0[4 * g + 3]);
                    const float s1 = (l1[4 * g] * l1[4 * g + 1]) * (l1[4 * g + 2] * l1[4 * g + 3]);
                    auto ra = __builtin_amdgcn_permlane32_swap(__float_as_uint(s0), __float_as_uint(s0), false, false);
                    auto rb = __builtin_amdgcn_permlane32_swap(__float_as_uint(s1), __float_as_uint(s1), false, false);
                    S[2 * g] = __uint_as_float(ra[0]); S[2 * g + 1] = __uint_as_float(ra[1]); S[8 + 2 * g] = __uint_as_float(rb[0]); S[8 + 2 * g + 1] = __uint_as_float(rb[1]);
                }
                float suf[16]; suf[15] = crun;
#pragma unroll
                for (int g = 14; g >= 0; --g) suf[g] = suf[g + 1] * S[g + 1];
                crun = suf[0] * S[0];
#pragma unroll
                for (int g = 0; g < 4; ++g) {
                    { const float e3 = hi ? suf[2 * g + 1] : suf[2 * g], e2 = e3 * l0[4 * g + 3], e1 = e2 * l0[4 * g + 2], e0 = e1 * l0[4 * g + 1];
                      p0[4 * g] *= e0; p0[4 * g + 1] *= e1; p0[4 * g + 2] *= e2; p0[4 * g + 3] *= e3; }
                    { const float e3 = hi ? suf[8 + 2 * g + 1] : suf[8 + 2 * g], e2 = e3 * l1[4 * g + 3], e1 = e2 * l1[4 * g + 2], e0 = e1 * l1[4 * g + 1];
                      p1[4 * g] *= e0; p1[4 * g + 1] *= e1; p1[4 * g + 2] *= e2; p1[4 * g + 3] *= e3; }
                }
                pv_tile<2>(o, vfb + cur * 34048, p0, p1);
                float mx = crun;
#pragma unroll
                for (int off = 1; off < 32; off <<= 1) mx = fmaxf(mx, __shfl_xor(mx, off));
                if (mx <= SB_MASS) active = false;
            }
            if (lane == 0) flags[cur * 8 + w] = active ? 0.f : 1.f;
            if (t > 0) kv_lstore(st, lds + (cur ^ 1) * 34048, map);
            __syncthreads();
            float fs = 0.f;
#pragma unroll
            for (int i = 0; i < 8; ++i) fs += flags[cur * 8 + i];
            if (fs >= 7.5f) break;
        }
#pragma unroll
        for (int db = 0; db < 2; ++db)
#pragma unroll
            for (int r = 0; r < 16; ++r) E[(32 * jw + crow(r, hi)) * 132 + 64 * c + 32 * db + r32] = o[db][r];
        __syncthreads();
        row_pass<0>(E, tid, rowbase + q0, col0, Gt, Ot, nullptr, 1.f);
        __syncthreads();
    }
}

#define DSB() __builtin_amdgcn_sched_barrier(0)
#define EXP4_ASM(P, R, S0, S1) asm volatile("v_exp_f32_e32 %0, %0\n\tv_exp_f32_e32 %1, %1\n\tv_exp_f32_e32 %2, %2\n\tv_exp_f32_e32 %3, %3\n\t" \
    "v_add_f32_e32 %4, %4, %0\n\tv_add_f32_e32 %5, %5, %1\n\tv_add_f32_e32 %4, %4, %2\n\tv_add_f32_e32 %5, %5, %3" \
    : "+v"(P[R]), "+v"(P[R + 1]), "+v"(P[R + 2]), "+v"(P[R + 3]), "+v"(S0), "+v"(S1))
#define EXP4_FIRST(P, S0, S1) do { P[0] = __builtin_amdgcn_exp2f(P[0]); P[1] = __builtin_amdgcn_exp2f(P[1]); P[2] = __builtin_amdgcn_exp2f(P[2]); P[3] = __builtin_amdgcn_exp2f(P[3]); \
    S0 = P[0] + P[2]; S1 = P[1] + P[3]; } while (0)
__device__ __forceinline__ void diff_tile(f32x16 (&o)[4], float& lsum, const LAS unsigned char* kb, const LAS unsigned char* vb, const bf16x8 (&qr)[4], float negm, bool need_mask, int lim) {
    f32x16 p0, p1;
#pragma unroll
    for (int r = 0; r < 16; ++r) { p0[r] = negm; p1[r] = negm; }
    bf16x8 kf[8];
#define KADDR(i) (kb + ((i) & 3) * 2112 + ((i) >> 2) * 512)
#define VADDR(i) (vb + ((i) & 3) * 4160 + ((i) >> 2) * 1024)
    kf[0] = *(const LAS bf16x8*)KADDR(0); kf[1] = *(const LAS bf16x8*)KADDR(1); kf[2] = *(const LAS bf16x8*)KADDR(2);
    DSB();
#pragma unroll
    for (int i = 0; i < 4; ++i) { kf[i + 3] = *(const LAS bf16x8*)KADDR(i + 3); p0 = MFMA32(kf[i], qr[i], p0); DSB(); }
    float s0, s1, s2, s3;
    s16x4 lo[16], hh[16];
    kf[7] = *(const LAS bf16x8*)KADDR(7); p1 = MFMA32(kf[4], qr[0], p1);
    if (need_mask) {
#pragma unroll
        for (int r = 0; r < 16; ++r) if ((r & 3) + 8 * (r >> 2) > lim) p0[r] = -INFINITY; }
    EXP4_FIRST(p0, s0, s1); DSB();
    p1 = MFMA32(kf[5], qr[1], p1); EXP4_ASM(p0, 4, s0, s1); DSB();
    p1 = MFMA32(kf[6], qr[2], p1); EXP4_ASM(p0, 8, s0, s1); lo[0] = vtr(VADDR(0)); hh[0] = vtr(VADDR(0) + 512); DSB();
    p1 = MFMA32(kf[7], qr[3], p1); EXP4_ASM(p0, 12, s0, s1); lo[1] = vtr(VADDR(1)); hh[1] = vtr(VADDR(1) + 512); DSB();
    bf16x8 pa[4];
    { u32x4 w;
      w = (u32x4){cvtpk(p0[0], p0[1]), cvtpk(p0[2], p0[3]), cvtpk(p0[4], p0[5]), cvtpk(p0[6], p0[7])}; pa[0] = __builtin_bit_cast(bf16x8, w);
      w = (u32x4){cvtpk(p0[8], p0[9]), cvtpk(p0[10], p0[11]), cvtpk(p0[12], p0[13]), cvtpk(p0[14], p0[15])}; pa[1] = __builtin_bit_cast(bf16x8, w); }
    lo[2] = vtr(VADDR(2)); hh[2] = vtr(VADDR(2) + 512);
    DSB();
#define PVSTEP(i) do { if ((i) + 3 < 16) { lo[(i) + 3] = vtr(VADDR((i) + 3)); hh[(i) + 3] = vtr(VADDR((i) + 3) + 512); } \
        { const bf16x8 vf_ = {lo[i][0], lo[i][1], lo[i][2], lo[i][3], hh[i][0], hh[i][1], hh[i][2], hh[i][3]}; o[(i) & 3] = MFMA32(pa[(i) >> 2], vf_, o[(i) & 3]); } } while (0)
    PVSTEP(0);
    if (need_mask) {
#pragma unroll
        for (int r = 0; r < 16; ++r) if (32 + (r & 3) + 8 * (r >> 2) > lim) p1[r] = -INFINITY; }
    EXP4_FIRST(p1, s2, s3); DSB();
    PVSTEP(1); DSB();
    PVSTEP(2); EXP4_ASM(p1, 4, s2, s3); DSB();
    PVSTEP(3); DSB();
    PVSTEP(4); EXP4_ASM(p1, 8, s2, s3); DSB();
    PVSTEP(5); DSB();
    PVSTEP(6); EXP4_ASM(p1, 12, s2, s3); DSB();
    PVSTEP(7);
    { u32x4 w;
      w = (u32x4){cvtpk(p1[0], p1[1]), cvtpk(p1[2], p1[3]), cvtpk(p1[4], p1[5]), cvtpk(p1[6], p1[7])}; pa[2] = __builtin_bit_cast(bf16x8, w);
      w = (u32x4){cvtpk(p1[8], p1[9]), cvtpk(p1[10], p1[11]), cvtpk(p1[12], p1[13]), cvtpk(p1[14], p1[15])}; pa[3] = __builtin_bit_cast(bf16x8, w); }
    DSB();
#pragma unroll
    for (int i = 8; i < 16; ++i) { PVSTEP(i); DSB(); }
    lsum += (s0 + s1) + (s2 + s3);
#undef PVSTEP
#undef KADDR
#undef VADDR
}
__device__ __forceinline__ void diff_attn_phase(LAS unsigned char* lds, int vcu, int G, const bf16* Qt, const bf16* Kt, const bf16* Vt, const bf16* Gt, bf16* Ot,
                                                const float* qg, const float* kg, const float* lamp, const float* subg) {
    int tid_ = threadIdx.x; asm volatile("" : "+v"(tid_)); const int tid = tid_, lane = tid & 63, w = __builtin_amdgcn_readfirstlane(tid >> 6), r32 = lane & 31, hi = lane >> 5;
    const int c = w >> 2, jw = w & 3;
    float lam, post, negm;
    { float a = lamp[lane] * lamp[64 + lane], bb = lamp[128 + lane] * lamp[192 + lane]; a = wave_sum(a); bb = wave_sum(bb);
      const float lam_init = 0.8f - 0.6f * expf(-0.3f); lam = expf(a) - expf(bb) + lam_init; post = 1.0f - lam_init;
      const float gq = wave_max(fabsf(qg[lane])), gk = wave_max(fabsf(kg[lane])); negm = -(8.0f * gq * gk * LOG2E); }
    const KVMap map = kv_map(w, lane);
    const LAS unsigned char* kfb = lds + c * 8448 + hi * 1056 + r32 * 16;
    const LAS unsigned char* vfb = lds + 17408 + (4 * hi + ((lane & 15) >> 2)) * 64 + ((lane >> 4) & 1) * 32 + (lane & 3) * 8;
    LAS float* E = (LAS float*)lds;
    LAS float* wsf = (LAS float*)(lds + DIFF_WSF) + w * 64;
    for (int pi = vcu; pi < 512; pi += G) {
        const int bh = pi >> 5, jj = pi & 31, b = bh >> 3, h = bh & 7;
        const size_t rowbase = (size_t)b * SEQ; const int col0 = h * 128;
        for (int uu = 0; uu < 2; ++uu) {
            const int qb = uu ? 63 - jj : jj, q0 = qb * 128, q0w = q0 + 32 * jw, qrow = q0w + r32, NTL = 2 * qb + 2;
            bf16x8 qr[4];
#pragma unroll
            for (int d0 = 0; d0 < 4; ++d0) qr[d0] = *(const bf16x8*)(Qt + (rowbase + qrow) * DM + col0 + c * 64 + d0 * 16 + hi * 8);
            f32x16 o[4];
#pragma unroll
            for (int r = 0; r < 16; ++r) { o[0][r] = 0.f; o[1][r] = 0.f; o[2][r] = 0.f; o[3][r] = 0.f; }
            float lsum = 0.f;
            KVStage st;
            kv_gload(st, Kt + rowbase * DM + col0, Vt + rowbase * DM + col0, map);
            kv_lstore(st, lds, map);
            kv_gload(st, Kt + (rowbase + 64) * DM + col0, Vt + (rowbase + 64) * DM + col0, map);
            kv_lstore(st, lds + 34048, map);
            __builtin_amdgcn_s_waitcnt(0);
            __syncthreads();
            const int NS = NTL >> 1;
            for (int u = 0; u < NS; ++u) {
                const int cb = (u & 1) * 68096, nb = cb ^ 68096; const bool more = (u + 1 < NS);
                if (more) kv_gload(st, Kt + (rowbase + 64 * (2 * u + 2)) * DM + col0, Vt + (rowbase + 64 * (2 * u + 2)) * DM + col0, map);
#pragma unroll
                for (int j = 0; j < 2; ++j) {
                    const int t = 2 * u + j;
                    if (64 * t <= q0w + 31) { int lim = qrow - 64 * t - 4 * hi; asm volatile("" : "+v"(lim));
                        diff_tile(o, lsum, kfb + cb + j * 34048, vfb + cb + j * 34048, qr, negm, 64 * t + 63 > q0w, lim); }
                    if (more) { kv_lstore(st, lds + nb + j * 34048, map);
                        if (j == 0) kv_gload(st, Kt + (rowbase + 64 * (2 * u + 3)) * DM + col0, Vt + (rowbase + 64 * (2 * u + 3)) * DM + col0, map); }
                }
                __syncthreads();
            }
            { auto rr = __builtin_amdgcn_permlane32_swap(__float_as_uint(lsum), __float_as_uint(lsum), false, false); lsum = __uint_as_float(rr[0]) + __uint_as_float(rr[1]); }
            if (hi == 0) wsf[r32] = (c ? lam : 1.0f) / lsum;
            float rli[16];
#pragma unroll
            for (int r = 0; r < 16; ++r) rli[r] = wsf[crow(r, hi)];
            if (c == 1) {
#pragma unroll
                for (int db = 0; db < 4; ++db)
#pragma unroll
                    for (int r = 0; r < 16; ++r) E[(32 * jw + crow(r, hi)) * 132 + 32 * db + r32] = o[db][r] * rli[r];
            }
            __syncthreads();
            if (c == 0) {
#pragma unroll
                for (int db = 0; db < 4; ++db)
#pragma unroll
                    for (int r = 0; r < 16; ++r) { LAS float* e = E + (32 * jw + crow(r, hi)) * 132 + 32 * db + r32; *e = o[db][r] * rli[r] - *e; }
            }
            __syncthreads();
            row_pass<1>(E, tid, rowbase + q0, col0, Gt, Ot, subg, post);
            __syncthreads();
        }
    }
}

__device__ __forceinline__ unsigned f2bf(float f) { unsigned u = __builtin_bit_cast(unsigned, f); return (u + 0x7fffu + ((u >> 16) & 1u)) >> 16; }
__device__ __forceinline__ unsigned pk2(float lo, float hi) { return f2bf(lo) | (f2bf(hi) << 16); }
__device__ __forceinline__ void p0_transpose_item(const float* W, const float* g, int K, int N, bf16* WT, int row_off, LAS float* scr, int item, int lane, int perm_below = 0) {
    const int nblk = N / 32, kb = item / nblk, nb = item % nblk, k0 = 64 * kb, n0 = 32 * nb;
    const int np0 = (n0 < perm_below) ? ((n0 & ~255) + 128 * ((n0 >> 5) & 1) + 32 * ((n0 & 255) >> 6)) : n0;
    float wv[32];
#pragma unroll
    for (int i = 0; i < 32; ++i) { const int kk = 2 * i + (lane >> 5); const float gv = g ? g[k0 + kk] : 1.0f; wv[i] = W[(size_t)(k0 + kk) * N + n0 + (lane & 31)] * gv; }
#pragma unroll
    for (int i = 0; i < 32; ++i) { const int kk = 2 * i + (lane >> 5); scr[kk * 33 + (lane & 31)] = wv[i]; }
    asm volatile("s_waitcnt lgkmcnt(0)" ::: "memory");
    const int cc = lane & 7;
#pragma unroll
    for (int j = 0; j < 4; ++j) { const int n = (lane >> 3) + 8 * j; const LAS float* s = scr + (8 * cc) * 33 + n;
        u32x4 o; o.x = pk2(s[0 * 33], s[1 * 33]); o.y = pk2(s[2 * 33], s[3 * 33]); o.z = pk2(s[4 * 33], s[5 * 33]); o.w = pk2(s[6 * 33], s[7 * 33]);
        *(u32x4*)(WT + (size_t)(row_off + np0 + n) * K + k0 + 8 * cc) = o; }
    asm volatile("s_waitcnt lgkmcnt(0)" ::: "memory");
}
__device__ __forceinline__ void rms_row_to_bf16(const float* xrow, bf16* orow, int lane) {
    const f32x4* xr = (const f32x4*)xrow + lane;
    f32x4 v[4]; float s = 0.f;
#pragma unroll
    for (int j = 0; j < 4; ++j) { v[j] = xr[64 * j]; s += (v[j].x * v[j].x + v[j].y * v[j].y) + (v[j].z * v[j].z + v[j].w * v[j].w); }
    const float rstd = 1.0f / sqrtf(wave_sum(s) * (1.0f / DM) + EPS);
    unsigned long long* o8 = (unsigned long long*)orow + lane;
#pragma unroll
    for (int j = 0; j < 4; ++j) o8[64 * j] = (unsigned long long)pk2(v[j].x * rstd, v[j].y * rstd) | ((unsigned long long)pk2(v[j].z * rstd, v[j].w * rstd) << 32);
}
__device__ __forceinline__ void qk_norm_rope_item(bf16* Kraw, bf16* Qraw, const float* kg, const float* qg, const f32x2* rope, int idx) {
    const int row = idx >> 5, c32 = idx & 31; const bool isq = c32 >= 16;
    bf16* p = (isq ? Qraw : Kraw) + (size_t)row * DM + (c32 & 15) * 64; const float* g = isq ? qg : kg;
    u32x4 raw[8];
#pragma unroll
    for (int i = 0; i < 8; ++i) raw[i] = *(const u32x4*)(p + 8 * i);
    float v[64]; float ss = 0.f;
#pragma unroll
    for (int i = 0; i < 8; ++i)
#pragma unroll
        for (int j = 0; j < 4; ++j) { const float lo = __uint_as_float(raw[i][j] << 16), hi = __uint_as_float(raw[i][j] & 0xffff0000u); v[8 * i + 2 * j] = lo; v[8 * i + 2 * j + 1] = hi; ss += lo * lo + hi * hi; }
    const float rstd = (isq ? QS : 1.0f) / sqrtf(ss * (1.0f / 64.0f) + EPS);
    const f32x2* cs = rope + (size_t)row * 32;
#pragma unroll
    for (int i = 0; i < 32; ++i) { const f32x2 t = cs[i]; const float t1 = v[i] * rstd * g[i], t2 = v[i + 32] * rstd * g[i + 32]; v[i] = t1 * t.x - t2 * t.y; v[i + 32] = t2 * t.x + t1 * t.y; }
#pragma unroll
    for (int i = 0; i < 8; ++i) { u32x4 o;
#pragma unroll
        for (int j = 0; j < 4; ++j) o[j] = cvtpk(v[8 * i + 2 * j], v[8 * i + 2 * j + 1]);
        *(u32x4*)(p + 8 * i) = o; }
}

struct Args { const float* x; const int* pos; const float* a_norm_g; const float* a_w_in; const float* a_w_out; const float* kv_norm_g; const float* w_kv; const float* k_norm_g;
              const float* b_norm_g; const float* b_w_in; const float* b_q_norm_g; const float* b_lambda; const float* b_subln_g; const float* b_w_out; float* out; unsigned char* ws; int cg_seams; int pad_; };

__global__ void __launch_bounds__(NTHR, 2) yoco_fwd(Args a) {
    extern __shared__ __attribute__((aligned(16))) unsigned char lds_raw[];
    LAS unsigned char* lds = (LAS unsigned char*)lds_raw;
    cg::grid_group grid = cg::this_grid();
    const int tid = threadIdx.x, lane = tid & 63, wave = __builtin_amdgcn_readfirstlane(tid >> 6);
    const int G = gridDim.x, bx = blockIdx.x, vcu = (G % 8 == 0) ? (bx % 8) * (G / 8) + bx / 8 : bx;
    unsigned char* ws = a.ws;
    if (tid < 16) ((LAS unsigned*)(lds + LDS_CTL))[tid] = 0u;
    __syncthreads();
    const XcdBarrier bar = xcd_barrier_post((unsigned*)(ws + WS_BAR), (volatile LAS unsigned*)(lds + LDS_CTL));
    float* sumsq = (float*)(ws + WS_SUMSQ); f32x2* rope = (f32x2*)(ws + WS_ROPE);
    bf16* WinA = (bf16*)(ws + WS_WINA); bf16* WoutA = (bf16*)(ws + WS_WOUTA); bf16* WB = (bf16*)(ws + WS_WB); bf16* WoutB = (bf16*)(ws + WS_WOUTB);
    bf16* XA = (bf16*)(ws + WS_XA); bf16* T0 = (bf16*)(ws + WS_T); bf16* T1 = T0 + TSTRIDE; bf16* T2 = T1 + TSTRIDE; bf16* T3 = T2 + TSTRIDE; bf16* OB = (bf16*)(ws + WS_O);

    {
        LAS float* scr = (LAS float*)(lds + wave * 16384);
        const int gw = vcu * NWAVES + wave, NGW = G * NWAVES;
        constexpr int I_INA = 16 * 128, I_OUT = 16 * 32, I_KV = 16 * 64, I_BIN = 16 * 64;
        constexpr int NITEMS = I_INA + I_OUT + I_KV + I_BIN + I_OUT;
        for (int it = gw; it < NITEMS; it += NGW) {
            int r = it;
            if (r < I_INA) { p0_transpose_item(a.a_w_in, a.a_norm_g, DM, 4096, WinA, 0, scr, r, lane); continue; } r -= I_INA;
            if (r < I_OUT) { p0_transpose_item(a.a_w_out, nullptr, DM, DM, WoutA, 0, scr, r, lane); continue; } r -= I_OUT;
            if (r < I_KV) { p0_transpose_item(a.w_kv, a.kv_norm_g, DM, 2048, WB, 0, scr, r, lane, 1024); continue; } r -= I_KV;
            if (r < I_BIN) { p0_transpose_item(a.b_w_in, a.b_norm_g, DM, 2048, WB, 2048, scr, r, lane, 1024); continue; } r -= I_BIN;
            p0_transpose_item(a.b_w_out, nullptr, DM, DM, WoutB, 0, scr, r, lane);
        }
        for (int m = gw; m < M; m += 2 * NGW) {
            const f32x4* xa0 = (const f32x4*)(a.x + (size_t)m * DM) + lane; const int m1 = (m + NGW < M) ? m + NGW : m; const f32x4* xa1 = (const f32x4*)(a.x + (size_t)m1 * DM) + lane;
            f32x4 v0[4], v1[4]; float q0 = 0.f, q1 = 0.f;
#pragma unroll
            for (int j = 0; j < 4; ++j) { v0[j] = xa0[64 * j]; v1[j] = xa1[64 * j]; }
#pragma unroll
            for (int j = 0; j < 4; ++j) { q0 += (v0[j].x * v0[j].x + v0[j].y * v0[j].y) + (v0[j].z * v0[j].z + v0[j].w * v0[j].w); q1 += (v1[j].x * v1[j].x + v1[j].y * v1[j].y) + (v1[j].z * v1[j].z + v1[j].w * v1[j].w); }
            const float r0 = 1.0f / sqrtf(wave_sum(q0) * (1.0f / DM) + EPS), r1 = 1.0f / sqrtf(wave_sum(q1) * (1.0f / DM) + EPS);
            unsigned long long* o0 = (unsigned long long*)(XA + (size_t)m * DM) + lane; unsigned long long* o1 = (unsigned long long*)(XA + (size_t)m1 * DM) + lane;
#pragma unroll
            for (int j = 0; j < 4; ++j) { o0[64 * j] = (unsigned long long)pk2(v0[j].x * r0, v0[j].y * r0) | ((unsigned long long)pk2(v0[j].z * r0, v0[j].w * r0) << 32);
                o1[64 * j] = (unsigned long long)pk2(v1[j].x * r1, v1[j].y * r1) | ((unsigned long long)pk2(v1[j].z * r1, v1[j].w * r1) << 32); }
        }
        const int gt = vcu * NTHR + tid, NGT = G * NTHR;
        for (int idx = gt; idx < M * 32; idx += NGT) {
            const int row = idx >> 5, i = idx & 31;
            const float inv = (float)exp2(-(double)i * (13.287712379549449 / 32.0));
            const float ang = (float)a.pos[row] * inv;
            const double ad = (double)ang; const double kq = rint(ad * 0.15915494309189535);
            double rr = fma(-kq, 6.283185307179586, ad); rr = fma(-kq, 2.4492935982947064e-16, rr);
            const float rf = (float)rr;
            rope[idx] = (f32x2){cosf(rf), sinf(rf)};
        }
    }
    if (a.cg_seams) grid.sync(); else xcd_barrier(bar);
    { pg8::Gemm g{XA, WinA, M, 4096, DM}; pg8::StaticOrder S; S.init(M, 4096, G, bx);
      pg8::EpiSplit4 E{T0, TSTRIDE, nullptr, QS, 0, 3};
      pg8::gemm_phase<pg8::EpiSplit4, pg8::StaticOrder, true, true>(lds, g, S, E); }
    if (a.cg_seams) grid.sync(); else xcd_barrier(bar);
    stick_attn_phase(lds, vcu, G, T0, T1, T2, T3, OB);
    if (a.cg_seams) grid.sync(); else xcd_barrier(bar);
    { pg8::Gemm g{OB, WoutA, M, DM, DM}; pg8::StaticOrder S; S.init(M, DM, G, bx);
      pg8::EpiRes E{a.x, nullptr, XA, sumsq};
      pg8::gemm_phase<pg8::EpiRes, pg8::StaticOrder, true, true>(lds, g, S, E); }
    if (a.cg_seams) grid.sync(); else xcd_barrier(bar);
    { pg8::Gemm g{XA, WB, M, 4096, DM}; pg8::StaticOrder S; S.init(M, 4096, G, bx);
      pg8::EpiB E{T0, TSTRIDE, sumsq, a.k_norm_g, a.b_q_norm_g, (const float*)rope, QS};
      pg8::gemm_phase<pg8::EpiB, pg8::StaticOrder, true, true>(lds, g, S, E); }
    if (a.cg_seams) grid.sync(); else xcd_barrier(bar);
    diff_attn_phase(lds, vcu, G, T2, T0, T1, T3, OB, a.b_q_norm_g, a.k_norm_g, a.b_lambda, a.b_subln_g);
    if (a.cg_seams) grid.sync(); else xcd_barrier(bar);
    { pg8::Gemm g{OB, WoutB, M, DM, DM}; pg8::StaticOrder S; S.init(M, DM, G, bx);
      pg8::EpiResBf E{XA, a.out};
      pg8::gemm_phase<pg8::EpiResBf, pg8::StaticOrder, true, true>(lds, g, S, E); }
}
}

extern "C" void kernel_launch(void* const* d_in, const int* in_sizes, int n_in, void* d_out, int out_size, void* d_ws, size_t ws_size, hipStream_t stream) {
    static int grid = 0;
    if (grid == 0) {
        if (n_in != 14 || in_sizes[0] != mk::M * mk::DM || out_size != mk::M * mk::DM || ws_size < mk::WS_END) { fprintf(stderr, "kernel_launch: unexpected shapes (n_in %d, ws %zu); nothing launched\n", n_in, ws_size); grid = -1; return; }
        int dev = 0, cus = 0, per_cu = 0;
        if (hipGetDevice(&dev) != hipSuccess || hipDeviceGetAttribute(&cus, hipDeviceAttributeMultiprocessorCount, dev) != hipSuccess) { grid = -1; return; }
        if (hipFuncSetAttribute((const void*)mk::yoco_fwd, hipFuncAttributeMaxDynamicSharedMemorySize, mk::LDS_BYTES) != hipSuccess) { fprintf(stderr, "kernel_launch: hipFuncSetAttribute failed\n"); grid = -1; return; }
        if (hipOccupancyMaxActiveBlocksPerMultiprocessor(&per_cu, (const void*)mk::yoco_fwd, mk::NTHR, mk::LDS_BYTES) != hipSuccess || per_cu < 1) { fprintf(stderr, "kernel_launch: occupancy query gave %d\n", per_cu); (void)hipGetLastError(); per_cu = 1; }
        grid = cus * per_cu;
    }
    if (grid < 0) return;
    (void)hipMemsetAsync((char*)d_ws, 0, 512 * 1024, stream);
    mk::Args a{};
    a.x = (const float*)d_in[0]; a.pos = (const int*)d_in[1]; a.a_norm_g = (const float*)d_in[2]; a.a_w_in = (const float*)d_in[3]; a.a_w_out = (const float*)d_in[4];
    a.kv_norm_g = (const float*)d_in[5]; a.w_kv = (const float*)d_in[6]; a.k_norm_g = (const float*)d_in[7]; a.b_norm_g = (const float*)d_in[8]; a.b_w_in = (const float*)d_in[9];
    a.b_q_norm_g = (const float*)d_in[10]; a.b_lambda = (const float*)d_in[11]; a.b_subln_g = (const float*)d_in[12]; a.b_w_out = (const float*)d_in[13];
    a.out = (float*)d_out; a.ws = (unsigned char*)d_ws;
    void* args[] = {&a};
    const hipError_t e = hipLaunchCooperativeKernel((const void*)mk::yoco_fwd, dim3(grid), dim3(mk::NTHR), args, mk::LDS_BYTES, stream);
    if (e != hipSuccess) fprintf(stderr, "kernel_launch: cooperative launch failed: %s (grid %d)\n", hipGetErrorString(e), grid);
}
```

```cpp
#include <hip/hip_runtime.h>
#include <hip/hip_cooperative_groups.h>
#include <cstdio>
#include <cstdint>
#include <cmath>
namespace cg = cooperative_groups;
namespace pg8 {
#define PG8_LAS __attribute__((address_space(3)))
typedef unsigned short bf16_t;
typedef short bf16x8 __attribute__((ext_vector_type(8)));
typedef float f32x4 __attribute__((ext_vector_type(4)));
typedef unsigned u32x4 __attribute__((ext_vector_type(4)));
constexpr int BM = 256, BK = 64, HALF = 128, HTB = HALF * BK * 2  , STAGE_BYTES = 8 * HTB, NXCD = 8, WGM = 8;

__host__ __device__ __forceinline__ int lds_byte(int r, int c) { const int st = (r >> 4) * 2 + (c >> 5), rr = r & 15, cc = c & 31, ob = rr * 64 + cc * 2; return st * 1024 + (ob ^ (((ob >> 9) & 1) << 5)); }
__host__ __device__ __forceinline__ void stage_rc(int b, int& R, int& C) { const int st = b / 1024, sb = b % 1024, swz = sb ^ (((sb >> 9) & 1) << 5); R = (st >> 1) * 16 + swz / 64; C = (st & 1) * 32 + (swz % 64) / 2; }
__host__ __device__ __forceinline__ int perm32(int rho) { const int n = rho >> 4, i = rho & 15; return 8 * (i >> 2) + 4 * n + (i & 3); }

struct Unit { int pm, pn; };
struct Gemm { const bf16_t* A; const bf16_t* Bt; int M, N, K; };

struct StaticOrder {
    int nM, nN, nwg, G, c;
    __host__ __device__ void init(int M, int N, int G_, int c_) { nM = M / BM; nN = N / BM; nwg = nM * nN; G = G_; c = c_; }
    __host__ __device__ bool next(int i, Unit& u) const {
        const long L = (long)i * G + c; if (L >= nwg) return false;
        int wgid = (int)L; { const int q = nwg / NXCD, r = nwg % NXCD, xcd = wgid % NXCD, off = wgid / NXCD; wgid = (xcd < r ? xcd * (q + 1) : r * (q + 1) + (xcd - r) * q) + off; }
        const int nig = WGM * nN, gid = wgid / nig, fm = gid * WGM, gsz = (nM - fm) < WGM ? (nM - fm) : WGM;
        u.pm = fm + ((wgid % nig) % gsz); u.pn = (wgid % nig) / gsz; return true;
    }
    __device__ __forceinline__ void a_ready(const Unit&) const {}
    __device__ __forceinline__ void done(const Unit&) const {}
};

__device__ __forceinline__ unsigned cvt_pk_bf16(float lo, float hi) { unsigned r; asm volatile("v_cvt_pk_bf16_f32 %0, %1, %2" : "=v"(r) : "v"(lo), "v"(hi)); return r; }
typedef float f32x2 __attribute__((ext_vector_type(2)));
__device__ __forceinline__ f32x2 gelu_pk(f32x2 v) {
    const f32x2 av = __builtin_elementwise_abs(v), d = av * 0.2316418882f + 1.0f;
    f32x2 t; t.x = __builtin_amdgcn_rcpf(d.x); t.y = __builtin_amdgcn_rcpf(d.y);
    f32x2 q = t * 0.5307027145f + (-0.7265760135f); q = q * t + 0.7107068705f; q = q * t + (-0.142248368f); q = q * t + 0.127414796f; q = q * t;
    const f32x2 s = (v * v) * (-0.72134752044f);
    f32x2 e; e.x = __builtin_amdgcn_exp2f(s.x); e.y = __builtin_amdgcn_exp2f(s.y);
    const f32x2 m = v * (q * e), r = v - m;
    f32x2 o; o.x = v.x < 0.f ? m.x : r.x; o.y = v.y < 0.f ? m.y : r.y; return o;
}

template <int ACT  > struct EpiBf16 {
    static constexpr bool PERM = true, AFTER_DRAIN = false; static_assert(ACT == 0 || ACT == 1, "EpiBf16: ACT is 0 (none) or 1 (gelu_pk)");
    bf16_t* O; int ldc; const float* bias; int split_cols; size_t split_stride; float scale0;
    __device__ __forceinline__ void operator()(const f32x4 (&acc)[2][2][4][2], const Unit& u, int wr, int wc, int fr, int fq) const {
        const int row0 = u.pm * BM + wr * 64 + fr; int colt = u.pn * BM; bf16_t* base = O;
        float sc = 1.f; if (split_cols) { const int t = colt / split_cols; base += (size_t)t * split_stride; colt -= t * split_cols; if (t == 0) sc = scale0; }
        const int col0 = colt + wc * 32 + 8 * fq, bcol0 = u.pn * BM + wc * 32 + 8 * fq;
        f32x4 bv[2][2];
#pragma unroll
        for (int bj = 0; bj < 2; ++bj)
#pragma unroll
            for (int n = 0; n < 2; ++n) bv[bj][n] = bias ? *(const f32x4*)(bias + bcol0 + bj * HALF + 4 * n) : (f32x4){0.f, 0.f, 0.f, 0.f};
#pragma unroll
        for (int ai = 0; ai < 2; ++ai)
#pragma unroll
            for (int m = 0; m < 4; ++m) { bf16_t* rowp = base + (size_t)(row0 + ai * HALF + m * 16) * ldc + col0;
#pragma unroll
                for (int bj = 0; bj < 2; ++bj) { f32x4 v0 = acc[ai][bj][m][0] + bv[bj][0], v1 = acc[ai][bj][m][1] + bv[bj][1];
                    if (ACT == 1) { f32x2 a = gelu_pk((f32x2){v0[0], v0[1]}), b = gelu_pk((f32x2){v0[2], v0[3]}), c = gelu_pk((f32x2){v1[0], v1[1]}), d = gelu_pk((f32x2){v1[2], v1[3]});
                        v0 = (f32x4){a.x, a.y, b.x, b.y}; v1 = (f32x4){c.x, c.y, d.x, d.y}; }
                    v0 = v0 * sc; v1 = v1 * sc; u32x4 w; w.x = cvt_pk_bf16(v0[0], v0[1]); w.y = cvt_pk_bf16(v0[2], v0[3]); w.z = cvt_pk_bf16(v1[0], v1[1]); w.w = cvt_pk_bf16(v1[2], v1[3]);
                    *(u32x4*)(rowp + bj * HALF) = w; } }
    }
};
template <class Epi, class Sched, bool ALIGN_EPI = false, bool SP2 = false>
__device__ __forceinline__ void gemm_phase(PG8_LAS unsigned char* lds, const Gemm g, const Sched& S, const Epi& E) {
    int tid_ = threadIdx.x; asm volatile("" : "+v"(tid_)); const int tid = tid_, wid = __builtin_amdgcn_readfirstlane(tid >> 6), lane = tid & 63, wr = wid >> 2, wc = wid & 3, fr = lane & 15, fq = lane >> 4;
    const int K = g.K, nt = K / BK;
    unsigned voffA[2], voffB[2];
#pragma unroll
    for (int i = 0; i < 2; ++i) { int R, C; stage_rc(tid * 16 + i * 8192, R, C); const int Rb = Epi::PERM ? ((R & ~31) + perm32(R & 31)) : R;
        voffA[i] = (unsigned)(R * K + C) * 2u; voffB[i] = (unsigned)(Rb * K + C) * 2u; }
    const size_t kstep = (size_t)(BK * 2);
    const size_t hstep = (size_t)HALF * K * 2;
    const size_t tstep = 2 * hstep;
    const unsigned ldsw = (unsigned)wid * 1024u;
    const int aoff = lds_byte(wr * 64 + fr, fq * 8), boff = lds_byte(wc * 32 + fr, fq * 8);
#define PG8_SA(b, h) (((b) * 2 + (h)) * HTB)
#define PG8_SB(b, h) ((4 + (b) * 2 + (h)) * HTB)
#define PG8_STAGE(bufoff, gbase, voff) do { _Pragma("unroll") for (int _i = 0; _i < 2; ++_i) \
        __builtin_amdgcn_global_load_lds((const unsigned*)((const char*)(gbase) + (voff)[_i]), (PG8_LAS unsigned*)(lds + (bufoff) + ldsw + _i * 8192), 16, 0, 0); } while (0)
#define PG8_LDA(dst, b, h) do { _Pragma("unroll") for (int m = 0; m < 4; ++m) _Pragma("unroll") for (int k = 0; k < 2; ++k) dst[m][k] = *(const PG8_LAS bf16x8*)(lds + PG8_SA(b, h) + aoff + m * 2048 + k * 1024); } while (0)
#define PG8_LDB(dst, b, h) do { _Pragma("unroll") for (int n = 0; n < 2; ++n) _Pragma("unroll") for (int k = 0; k < 2; ++k) dst[n][k] = *(const PG8_LAS bf16x8*)(lds + PG8_SB(b, h) + boff + n * 2048 + k * 1024); } while (0)
#define PG8_MMA(ai, bj, At, Bt) do { __builtin_amdgcn_s_setprio(1); _Pragma("unroll") for (int m = 0; m < 4; ++m) _Pragma("unroll") for (int n = 0; n < 2; ++n) _Pragma("unroll") for (int k = 0; k < 2; ++k) \
        acc[ai][bj][m][n] = __builtin_amdgcn_mfma_f32_16x16x32_bf16(Bt[n][k], At[m][k], acc[ai][bj][m][n], 0, 0, 0); __builtin_amdgcn_s_setprio(0); } while (0)
#define PG8_WAIT_V(n) asm volatile("s_waitcnt vmcnt(" #n ")" ::: "memory")
#define PG8_WAIT_L(n) asm volatile("s_waitcnt lgkmcnt(" #n ")" ::: "memory")
#define PG8_BAR __builtin_amdgcn_s_barrier()
#define PG8_SCHED __builtin_amdgcn_sched_barrier(0)
    Unit cur, nxt; int ui = 0;
    if (!S.next(0, cur)) return;
    f32x4 acc[2][2][4][2];
#pragma unroll
    for (int a = 0; a < 2; ++a)
#pragma unroll
        for (int b = 0; b < 2; ++b)
#pragma unroll
            for (int m = 0; m < 4; ++m)
#pragma unroll
                for (int n = 0; n < 2; ++n) acc[a][b][m][n] = (f32x4){0.f, 0.f, 0.f, 0.f};
    bf16x8 At[4][2], B0[2][2], B1[2][2];
    const char* cA = (const char*)g.A + (size_t)cur.pm * tstep; const char* cB = (const char*)g.Bt + (size_t)cur.pn * tstep;
    S.a_ready(cur);
    if constexpr (SP2) {
        PG8_STAGE(PG8_SB(0, 0), cB, voffB); PG8_STAGE(PG8_SB(0, 1), cB + hstep, voffB); PG8_STAGE(PG8_SA(0, 0), cA, voffA); PG8_STAGE(PG8_SA(0, 1), cA + hstep, voffA);
        if (wr == 1) PG8_BAR;
        PG8_WAIT_V(2); PG8_BAR;
        PG8_STAGE(PG8_SB(1, 0), cB + kstep, voffB); PG8_STAGE(PG8_SA(1, 0), cA + kstep, voffA); PG8_STAGE(PG8_SB(1, 1), cB + hstep + kstep, voffB);
        PG8_WAIT_V(6); PG8_BAR;
    } else {
        PG8_STAGE(PG8_SB(0, 0), cB, voffB); PG8_STAGE(PG8_SA(0, 0), cA, voffA); PG8_STAGE(PG8_SB(0, 1), cB + hstep, voffB); PG8_STAGE(PG8_SA(0, 1), cA + hstep, voffA);
        if (wr == 1) PG8_BAR;
        PG8_WAIT_V(4); PG8_BAR;
        PG8_STAGE(PG8_SB(1, 0), cB + kstep, voffB); PG8_STAGE(PG8_SA(1, 0), cA + kstep, voffA); PG8_STAGE(PG8_SB(1, 1), cB + hstep + kstep, voffB);
        PG8_WAIT_V(6); PG8_BAR;
    }
    for (;;) {
        const bool has_next = S.next(ui + 1, nxt);
        const char* nA = has_next ? (const char*)g.A + (size_t)nxt.pm * tstep : cA; const char* nB = has_next ? (const char*)g.Bt + (size_t)nxt.pn * tstep : cB;
        for (int t = 0; t < nt; t += 2) {
            const bool last = (t == nt - 2);
            const char* a1 = cA + (size_t)(t + 1) * kstep;
            const char* a2 = last ? nA : cA + (size_t)(t + 2) * kstep; const char* b2 = last ? nB : cB + (size_t)(t + 2) * kstep;
            const char* a3 = a2 + kstep; const char* b3 = b2 + kstep;
            if (last && has_next) S.a_ready(nxt);
            if constexpr (SP2) {
            PG8_LDB(B0, 0, 0); PG8_LDB(B1, 0, 1); PG8_SCHED; PG8_LDA(At, 0, 0); PG8_STAGE(PG8_SA(1, 1), a1 + hstep, voffA);
            PG8_WAIT_V(8); PG8_WAIT_L(0); PG8_BAR; PG8_MMA(0, 0, At, B0); PG8_MMA(0, 1, At, B1); PG8_BAR; PG8_SCHED;
            PG8_LDA(At, 0, 1); PG8_STAGE(PG8_SB(0, 0), b2, voffB); PG8_STAGE(PG8_SB(0, 1), b2 + hstep, voffB); PG8_STAGE(PG8_SA(0, 0), a2, voffA);
            PG8_WAIT_V(8); PG8_WAIT_L(0); PG8_BAR; PG8_MMA(1, 0, At, B0); PG8_MMA(1, 1, At, B1); PG8_BAR; PG8_SCHED;
            PG8_LDB(B0, 1, 0); PG8_LDB(B1, 1, 1); PG8_SCHED; PG8_LDA(At, 1, 0); PG8_STAGE(PG8_SA(0, 1), a2 + hstep, voffA);
            PG8_WAIT_V(8); PG8_WAIT_L(0); PG8_BAR; PG8_MMA(0, 0, At, B0); PG8_MMA(0, 1, At, B1); PG8_BAR; PG8_SCHED;
            PG8_LDA(At, 1, 1); PG8_STAGE(PG8_SB(1, 0), b3, voffB); PG8_STAGE(PG8_SB(1, 1), b3 + hstep, voffB); PG8_STAGE(PG8_SA(1, 0), a3, voffA);
            PG8_WAIT_V(8); PG8_WAIT_L(0); PG8_BAR; PG8_MMA(1, 0, At, B0); PG8_MMA(1, 1, At, B1); PG8_BAR; PG8_SCHED;
            } else {
            PG8_LDB(B0, 0, 0); PG8_SCHED; PG8_LDA(At, 0, 0); PG8_STAGE(PG8_SA(1, 1), a1 + hstep, voffA);
            PG8_WAIT_L(8); PG8_BAR; PG8_WAIT_L(0); PG8_MMA(0, 0, At, B0); PG8_BAR; PG8_SCHED;
            PG8_LDB(B1, 0, 1); PG8_STAGE(PG8_SB(0, 0), b2, voffB);
            PG8_BAR; PG8_WAIT_L(0); PG8_MMA(0, 1, At, B1); PG8_BAR;
            PG8_LDA(At, 0, 1); PG8_STAGE(PG8_SA(0, 0), a2, voffA);
            PG8_BAR; PG8_WAIT_L(0); PG8_MMA(1, 0, At, B0); PG8_BAR; PG8_SCHED;
            PG8_STAGE(PG8_SB(0, 1), b2 + hstep, voffB);
            PG8_WAIT_V(6); PG8_BAR; PG8_MMA(1, 1, At, B1); PG8_BAR;
            PG8_LDB(B0, 1, 0); PG8_SCHED; PG8_LDA(At, 1, 0); PG8_STAGE(PG8_SA(0, 1), a2 + hstep, voffA);
            PG8_WAIT_L(8); PG8_BAR; PG8_WAIT_L(0); PG8_MMA(0, 0, At, B0); PG8_BAR; PG8_SCHED;
            PG8_LDB(B1, 1, 1); PG8_STAGE(PG8_SB(1, 0), b3, voffB);
            PG8_BAR; PG8_WAIT_L(0); PG8_MMA(0, 1, At, B1); PG8_BAR;
            PG8_LDA(At, 1, 1); PG8_STAGE(PG8_SA(1, 0), a3, voffA);
            PG8_BAR; PG8_WAIT_L(0); PG8_MMA(1, 0, At, B0); PG8_BAR; PG8_SCHED;
            PG8_STAGE(PG8_SB(1, 1), b3 + hstep, voffB);
            PG8_WAIT_V(6); PG8_BAR; PG8_MMA(1, 1, At, B1); PG8_BAR;
            }
        }
        if constexpr (ALIGN_EPI) { if (wr == 0) PG8_BAR; }
        if constexpr (!Epi::AFTER_DRAIN) { E(acc, cur, wr, wc, fr, fq); S.done(cur); }
        if (!has_next) break;
#pragma unroll
        for (int a = 0; a < 2; ++a)
#pragma unroll
            for (int b = 0; b < 2; ++b)
#pragma unroll
                for (int m = 0; m < 4; ++m)
#pragma unroll
                    for (int n = 0; n < 2; ++n) acc[a][b][m][n] = (f32x4){0.f, 0.f, 0.f, 0.f};
        cur = nxt; cA = nA; cB = nB; ++ui;
        if constexpr (ALIGN_EPI) { if (wr == 1) PG8_BAR; }
    }
    PG8_WAIT_V(0);
    if constexpr (!ALIGN_EPI) { if (wr == 0) PG8_BAR; }
    PG8_BAR;
    if constexpr (Epi::AFTER_DRAIN) { E.fused(acc, cur, wr, wc, fr, fq, lds, wid, lane); S.done(cur); }
#undef PG8_SA
#undef PG8_SB
#undef PG8_STAGE
#undef PG8_LDA
#undef PG8_LDB
#undef PG8_MMA
#undef PG8_WAIT_V
#undef PG8_WAIT_L
#undef PG8_BAR
#undef PG8_SCHED
}
}
namespace pg8 {
__device__ __forceinline__ float silu_f(float x) { return x * __builtin_amdgcn_rcpf(1.0f + __builtin_amdgcn_exp2f(-1.4426950408889634f * x)); }
struct EpiSplit4 {
    static constexpr bool PERM = true, AFTER_DRAIN = false;
    bf16_t* O; size_t split_stride; const float* sumsq; float qscale; int q_split, gate_split;
    __device__ __forceinline__ void operator()(const f32x4 (&acc)[2][2][4][2], const Unit& u, int wr, int wc, int fr, int fq) const {
        const int row0 = u.pm * BM + wr * 64 + fr; int colt = u.pn * BM; const int t = colt >> 10; colt &= 1023;
        bf16_t* base = O + (size_t)t * split_stride; const int col0 = colt + wc * 32 + 8 * fq;
        const float ts = (t == q_split) ? qscale : 1.f; const bool gate = (t == gate_split);
#pragma unroll
        for (int ai = 0; ai < 2; ++ai)
#pragma unroll
            for (int m = 0; m < 4; ++m) { const int row = row0 + ai * HALF + m * 16; float rs = ts;
                if (sumsq) rs *= 1.0f / sqrtf(sumsq[row] * (1.0f / 1024.0f) + 1e-6f);
                bf16_t* rowp = base + (size_t)row * 1024 + col0;
#pragma unroll
                for (int bj = 0; bj < 2; ++bj) { f32x4 v0 = acc[ai][bj][m][0] * rs, v1 = acc[ai][bj][m][1] * rs;
                    if (gate) { v0 = (f32x4){silu_f(v0[0]), silu_f(v0[1]), silu_f(v0[2]), silu_f(v0[3])}; v1 = (f32x4){silu_f(v1[0]), silu_f(v1[1]), silu_f(v1[2]), silu_f(v1[3])}; }
                    u32x4 w; w.x = cvt_pk_bf16(v0[0], v0[1]); w.y = cvt_pk_bf16(v0[2], v0[3]); w.z = cvt_pk_bf16(v1[0], v1[1]); w.w = cvt_pk_bf16(v1[2], v1[3]);
                    *(u32x4*)(rowp + bj * HALF) = w; } }
    }
};
struct EpiRes {
    static constexpr bool PERM = true, AFTER_DRAIN = false;
    const float* base; float* out; bf16_t* xa; float* sumsq;
    __device__ __forceinline__ void load_batch(f32x4 (&b)[2][2][2], int q, int row0, int col0) const {
#pragma unroll
        for (int mm = 0; mm < 2; ++mm)
#pragma unroll
            for (int bj = 0; bj < 2; ++bj) { const size_t off = (size_t)(row0 + (q >> 1) * HALF + (2 * (q & 1) + mm) * 16) * 1024 + col0 + bj * HALF; b[mm][bj][0] = *(const f32x4*)(base + off); b[mm][bj][1] = *(const f32x4*)(base + off + 4); }
    }
    __device__ __forceinline__ void store_batch(const f32x4 (&b)[2][2][2], const f32x4 (&acc)[2][2][4][2], int q, int row0, int col0, int fq, int pslot) const {
#pragma unroll
        for (int mm = 0; mm < 2; ++mm) { const int ai = q >> 1, m = 2 * (q & 1) + mm; const int row = row0 + ai * HALF + m * 16; const size_t off = (size_t)row * 1024 + col0; float ss = 0.f;
#pragma unroll
            for (int bj = 0; bj < 2; ++bj) { const f32x4 v0 = b[mm][bj][0] + acc[ai][bj][m][0], v1 = b[mm][bj][1] + acc[ai][bj][m][1];
                if (out) { *(f32x4*)(out + off + bj * HALF) = v0; *(f32x4*)(out + off + bj * HALF + 4) = v1; }
                ss += (v0[0] * v0[0] + v0[1] * v0[1]) + (v0[2] * v0[2] + v0[3] * v0[3]) + (v1[0] * v1[0] + v1[1] * v1[1]) + (v1[2] * v1[2] + v1[3] * v1[3]);
                if (xa) { u32x4 w; w.x = cvt_pk_bf16(v0[0], v0[1]); w.y = cvt_pk_bf16(v0[2], v0[3]); w.z = cvt_pk_bf16(v1[0], v1[1]); w.w = cvt_pk_bf16(v1[2], v1[3]);
                    *(u32x4*)(xa + off + bj * HALF) = w; } }
            if (sumsq) { ss += __shfl_xor(ss, 16); ss += __shfl_xor(ss, 32); if (fq == 0) atomicAdd(sumsq + row, ss); } }
    }
    __device__ __forceinline__ void operator()(const f32x4 (&acc)[2][2][4][2], const Unit& u, int wr, int wc, int fr, int fq) const {
        const int row0 = u.pm * BM + wr * 64 + fr; const int col0 = u.pn * BM + wc * 32 + 8 * fq; const int pslot = u.pn * 4 + wc;
        f32x4 b0[2][2][2], b1[2][2][2];
        load_batch(b0, 0, row0, col0);
        load_batch(b1, 1, row0, col0); store_batch(b0, acc, 0, row0, col0, fq, pslot);
        load_batch(b0, 2, row0, col0); store_batch(b1, acc, 1, row0, col0, fq, pslot);
        load_batch(b1, 3, row0, col0); store_batch(b0, acc, 2, row0, col0, fq, pslot);
        store_batch(b1, acc, 3, row0, col0, fq, pslot);
    }
};

struct EpiResBf {
    static constexpr bool PERM = true, AFTER_DRAIN = false;
    const bf16_t* resid; float* out;
    __device__ __forceinline__ void operator()(const f32x4 (&acc)[2][2][4][2], const Unit& u, int wr, int wc, int fr, int fq) const {
        const int row0 = u.pm * BM + wr * 64 + fr; const int col0 = u.pn * BM + wc * 32 + 8 * fq;
        u32x4 r[2][4][2];
#pragma unroll
        for (int ai = 0; ai < 2; ++ai)
#pragma unroll
            for (int m = 0; m < 4; ++m)
#pragma unroll
                for (int bj = 0; bj < 2; ++bj) r[ai][m][bj] = *(const u32x4*)(resid + (size_t)(row0 + ai * HALF + m * 16) * 1024 + col0 + bj * HALF);
#pragma unroll
        for (int ai = 0; ai < 2; ++ai)
#pragma unroll
            for (int m = 0; m < 4; ++m) { const size_t off = (size_t)(row0 + ai * HALF + m * 16) * 1024 + col0;
#pragma unroll
                for (int bj = 0; bj < 2; ++bj) { const u32x4 w = r[ai][m][bj];
                    const f32x4 b0 = {__uint_as_float(w.x << 16), __uint_as_float(w.x & 0xffff0000u), __uint_as_float(w.y << 16), __uint_as_float(w.y & 0xffff0000u)};
                    const f32x4 b1 = {__uint_as_float(w.z << 16), __uint_as_float(w.z & 0xffff0000u), __uint_as_float(w.w << 16), __uint_as_float(w.w & 0xffff0000u)};
                    *(f32x4*)(out + off + bj * HALF) = acc[ai][bj][m][0] + b0; *(f32x4*)(out + off + bj * HALF + 4) = acc[ai][bj][m][1] + b1; } }
    }
};

struct EpiB {
    static constexpr bool PERM = true, AFTER_DRAIN = false;
    bf16_t* O; size_t split_stride; const float* sumsq; const float* kg; const float* qg; const float* rope; float qs; const float* subg; float post;
    __device__ __forceinline__ void operator()(const f32x4 (&acc)[2][2][4][2], const Unit& u, int wr, int wc, int fr, int fq) const {
        const int row0 = u.pm * BM + wr * 64 + fr; int colt = u.pn * BM; const int t = colt >> 10; colt &= 1023;
        bf16_t* base = O + (size_t)t * split_stride;
        float rsv[2][4];
#pragma unroll
        for (int ai = 0; ai < 2; ++ai)
#pragma unroll
            for (int m = 0; m < 4; ++m) rsv[ai][m] = __builtin_amdgcn_rsqf(sumsq[row0 + ai * HALF + m * 16] * (1.0f / 1024.0f) + 1e-6f);
        if (t & 1) {
            const int col0 = colt + wc * 32 + 8 * fq; const bool gate = (t == 3);
            f32x4 sg0 = {1.f, 1.f, 1.f, 1.f}, sg1 = sg0;
            if (gate) { sg0 = *(const f32x4*)(subg + wc * 32 + 8 * fq) * post; sg1 = *(const f32x4*)(subg + wc * 32 + 8 * fq + 4) * post; }
#pragma unroll
            for (int ai = 0; ai < 2; ++ai)
#pragma unroll
                for (int m = 0; m < 4; ++m) { const int row = row0 + ai * HALF + m * 16; const float rs = rsv[ai][m];
                    bf16_t* rowp = base + (size_t)row * 1024 + col0;
#pragma unroll
                    for (int bj = 0; bj < 2; ++bj) { f32x4 v0 = acc[ai][bj][m][0] * rs, v1 = acc[ai][bj][m][1] * rs;
                        if (gate) { v0 = (f32x4){silu_f(v0[0]), silu_f(v0[1]), silu_f(v0[2]), silu_f(v0[3])} * sg0; v1 = (f32x4){silu_f(v1[0]), silu_f(v1[1]), silu_f(v1[2]), silu_f(v1[3])} * sg1; }
                        u32x4 w; w.x = cvt_pk_bf16(v0[0], v0[1]); w.y = cvt_pk_bf16(v0[2], v0[3]); w.z = cvt_pk_bf16(v1[0], v1[1]); w.w = cvt_pk_bf16(v1[2], v1[3]);
                        *(u32x4*)(rowp + bj * HALF) = w; } }
        } else {
            const float* g = (t == 0) ? kg : qg; const float sc = (t == 2) ? qs : 1.0f;
            f32x4 g1[2], g2[2];
#pragma unroll
            for (int n = 0; n < 2; ++n) { g1[n] = *(const f32x4*)(g + 8 * fq + 4 * n) * sc; g2[n] = *(const f32x4*)(g + 32 + 8 * fq + 4 * n) * sc; }
            const int colc = colt + wc * 64 + 8 * fq;
#pragma unroll
            for (int ai = 0; ai < 2; ++ai)
#pragma unroll
                for (int m = 0; m < 4; ++m) { const int row = row0 + ai * HALF + m * 16; const float rs = rsv[ai][m];
                    f32x4 a1[2], a2[2]; float ss = 0.f;
#pragma unroll
                    for (int n = 0; n < 2; ++n) { a1[n] = acc[ai][0][m][n] * rs; a2[n] = acc[ai][1][m][n] * rs;
                        ss += (a1[n][0] * a1[n][0] + a1[n][1] * a1[n][1]) + (a1[n][2] * a1[n][2] + a1[n][3] * a1[n][3]) + (a2[n][0] * a2[n][0] + a2[n][1] * a2[n][1]) + (a2[n][2] * a2[n][2] + a2[n][3] * a2[n][3]); }
                    ss += __shfl_xor(ss, 16); ss += __shfl_xor(ss, 32);
                    const float cr = __builtin_amdgcn_rsqf(ss * (1.0f / 64.0f) + 1e-6f);
                    const f32x4* rp = (const f32x4*)(rope + ((size_t)row * 32 + 8 * fq) * 2);
                    f32x4 o1[2], o2[2];
#pragma unroll
                    for (int n = 0; n < 2; ++n) { const f32x4 t1 = a1[n] * cr * g1[n], t2 = a2[n] * cr * g2[n]; const f32x4 c0 = rp[2 * n], c1 = rp[2 * n + 1];
                        o1[n] = (f32x4){t1[0] * c0[0] - t2[0] * c0[1], t1[1] * c0[2] - t2[1] * c0[3], t1[2] * c1[0] - t2[2] * c1[1], t1[3] * c1[2] - t2[3] * c1[3]};
                        o2[n] = (f32x4){t2[0] * c0[0] + t1[0] * c0[1], t2[1] * c0[2] + t1[1] * c0[3], t2[2] * c1[0] + t1[2] * c1[1], t2[3] * c1[2] + t1[3] * c1[3]}; }
                    bf16_t* rowp = base + (size_t)row * 1024 + colc; u32x4 w;
                    w.x = cvt_pk_bf16(o1[0][0], o1[0][1]); w.y = cvt_pk_bf16(o1[0][2], o1[0][3]); w.z = cvt_pk_bf16(o1[1][0], o1[1][1]); w.w = cvt_pk_bf16(o1[1][2], o1[1][3]); *(u32x4*)(rowp) = w;
                    w.x = cvt_pk_bf16(o2[0][0], o2[0][1]); w.y = cvt_pk_bf16(o2[0][2], o2[0][3]); w.z = cvt_pk_bf16(o2[1][0], o2[1][1]); w.w = cvt_pk_bf16(o2[1][2], o2[1][3]); *(u32x4*)(rowp + 32) = w; }
        }
    }
};
}
namespace mk {
#define LAS __attribute__((address_space(3)))
typedef unsigned short bf16;
typedef unsigned u32x4 __attribute__((ext_vector_type(4)));
typedef float f32x4 __attribute__((ext_vector_type(4)));
typedef float f32x16 __attribute__((ext_vector_type(16)));
typedef short bf16x8 __attribute__((ext_vector_type(8)));
typedef short s16x4 __attribute__((ext_vector_type(4)));
typedef short v4i16_t __attribute__((ext_vector_type(4)));
typedef float f32x2 __attribute__((ext_vector_type(2)));

constexpr int BATCH = 2, SEQ = 8192, DM = 1024, M = BATCH * SEQ, NWAVES = 8, NTHR = 512;
constexpr float EPS = 1e-6f, LOG2E = 1.4426950408889634f, QS = 0.125f * LOG2E;
constexpr float SB_MASS = 2.3283064365386963e-10f;
constexpr size_t MiB = 1u << 20;
constexpr size_t WS_SUMSQ = 0;
constexpr size_t WS_BAR = 256 * 1024;
constexpr size_t WS_ROPE = 1 * MiB;
constexpr size_t WS_WINA = 5 * MiB;
constexpr size_t WS_WOUTA = 13 * MiB;
constexpr size_t WS_WB = 15 * MiB;
constexpr size_t WS_WOUTB = 23 * MiB;
constexpr size_t WS_XA = 32 * MiB;
constexpr size_t WS_T = 64 * MiB;
constexpr size_t WS_O = 192 * MiB;
constexpr size_t WS_END = 224 * MiB;
constexpr size_t TSTRIDE = (size_t)M * DM;
constexpr int RING_BYTES = 131072, LDS_BYTES = 143360;
constexpr int DIFF_WSF = 137216, LDS_CTL = 141312;
constexpr int ATT_WSF = 98304, ATT_FLAGS = 98304 + 2048;

__device__ __forceinline__ int crow(int r, int hi) { return (r & 3) + 8 * (r >> 2) + 4 * hi; }
__device__ __forceinline__ unsigned cvtpk(float lo, float hi) { typedef __bf16 b2 __attribute__((ext_vector_type(2))); f32x2 v = {lo, hi}; b2 b = __builtin_convertvector(v, b2); return __builtin_bit_cast(unsigned, b); }
__device__ __forceinline__ float bf2f(unsigned short b) { return __uint_as_float((unsigned)b << 16); }
__device__ __forceinline__ s16x4 vtr(const LAS unsigned char* p) { return __builtin_bit_cast(s16x4, __builtin_amdgcn_ds_read_tr16_b64_v4i16((LAS v4i16_t*)p)); }
__device__ __forceinline__ float wave_sum(float v) {
#pragma unroll
    for (int o = 1; o < 64; o <<= 1) v += __shfl_xor(v, o);
    return v;
}
__device__ __forceinline__ float wave_max(float v) {
#pragma unroll
    for (int o = 1; o < 64; o <<= 1) v = fmaxf(v, __shfl_xor(v, o));
    return v;
}
#define MFMA32(a, b, c) __builtin_amdgcn_mfma_f32_32x32x16_bf16(a, b, c, 0, 0, 0)

struct KVMap { int kg0, kg1, vg0, vg1, kl0, kl1, vl0, vl1; };
struct KVStage { u32x4 k0, k1, v0, v1; };
__device__ __forceinline__ KVMap kv_map(int w, int lane) {
    KVMap m; const int krow = 16 * (w >> 1) + (lane >> 2); const int kc0 = 8 * (w & 1) + (lane & 3), kc1 = kc0 + 4;
    m.kg0 = krow * DM + 8 * kc0; m.kg1 = krow * DM + 8 * kc1;
    m.kl0 = (kc0 >> 3) * 8448 + (kc0 & 7) * 1056 + krow * 16; m.kl1 = (kc1 >> 3) * 8448 + (kc1 & 7) * 1056 + krow * 16;
    const int vr0 = 8 * w + (lane >> 4), vr1 = vr0 + 4, vch = lane & 15;
    m.vg0 = vr0 * DM + 8 * vch; m.vg1 = vr1 * DM + 8 * vch;
    m.vl0 = 17408 + (vch >> 2) * 4160 + vr0 * 64 + (vch & 3) * 16; m.vl1 = 17408 + (vch >> 2) * 4160 + vr1 * 64 + (vch & 3) * 16;
    return m;
}
__device__ __forceinline__ void kv_gload(KVStage& s, const bf16* Kt, const bf16* Vt, const KVMap& m) {
    s.k0 = *(const u32x4*)(Kt + m.kg0); s.k1 = *(const u32x4*)(Kt + m.kg1); s.v0 = *(const u32x4*)(Vt + m.vg0); s.v1 = *(const u32x4*)(Vt + m.vg1);
}
__device__ __forceinline__ void kv_lstore(const KVStage& s, LAS unsigned char* buf, const KVMap& m) {
    *(LAS u32x4*)(buf + m.kl0) = s.k0; *(LAS u32x4*)(buf + m.kl1) = s.k1; *(LAS u32x4*)(buf + m.vl0) = s.v0; *(LAS u32x4*)(buf + m.vl1) = s.v1;
}
__device__ __forceinline__ void qk_tile(f32x16& p0, f32x16& p1, const LAS unsigned char* kb, const bf16x8 (&qr)[4], float init) {
#pragma unroll
    for (int r = 0; r < 16; ++r) { p0[r] = init; p1[r] = init; }
    constexpr int RD = 3;
    bf16x8 kf[8];
#define KADDR(i) (kb + ((i) >> 1) * 2112 + ((i) & 1) * 512)
#pragma unroll
    for (int i = 0; i < RD; ++i) kf[i] = *(const LAS bf16x8*)KADDR(i);
    __builtin_amdgcn_sched_barrier(0);
#pragma unroll
    for (int i = 0; i < 8; ++i) {
        if (i + RD < 8) kf[i + RD] = *(const LAS bf16x8*)KADDR(i + RD);
        if (i & 1) p1 = MFMA32(kf[i], qr[i >> 1], p1); else p0 = MFMA32(kf[i], qr[i >> 1], p0);
        __builtin_amdgcn_sched_barrier(0);
    }
#undef KADDR
}
template <int NDB> __device__ __forceinline__ void pv_tile(f32x16 (&o)[NDB], const LAS unsigned char* vb, const f32x16& p0, const f32x16& p1) {
    bf16x8 pa[4];
    { u32x4 w;
      w = (u32x4){cvtpk(p0[0], p0[1]), cvtpk(p0[2], p0[3]), cvtpk(p0[4], p0[5]), cvtpk(p0[6], p0[7])}; pa[0] = __builtin_bit_cast(bf16x8, w);
      w = (u32x4){cvtpk(p0[8], p0[9]), cvtpk(p0[10], p0[11]), cvtpk(p0[12], p0[13]), cvtpk(p0[14], p0[15])}; pa[1] = __builtin_bit_cast(bf16x8, w);
      w = (u32x4){cvtpk(p1[0], p1[1]), cvtpk(p1[2], p1[3]), cvtpk(p1[4], p1[5]), cvtpk(p1[6], p1[7])}; pa[2] = __builtin_bit_cast(bf16x8, w);
      w = (u32x4){cvtpk(p1[8], p1[9]), cvtpk(p1[10], p1[11]), cvtpk(p1[12], p1[13]), cvtpk(p1[14], p1[15])}; pa[3] = __builtin_bit_cast(bf16x8, w); }
    constexpr int N = 4 * NDB, RD = 3;
    s16x4 lo[N], hi[N];
#define VADDR(i) (vb + ((i) % NDB) * 4160 + ((i) / NDB) * 1024)
#pragma unroll
    for (int i = 0; i < RD; ++i) { lo[i] = vtr(VADDR(i)); hi[i] = vtr(VADDR(i) + 512); }
    __builtin_amdgcn_sched_barrier(0);
#pragma unroll
    for (int i = 0; i < N; ++i) {
        if (i + RD < N) { lo[i + RD] = vtr(VADDR(i + RD)); hi[i + RD] = vtr(VADDR(i + RD) + 512); }
        const bf16x8 vf = {lo[i][0], lo[i][1], lo[i][2], lo[i][3], hi[i][0], hi[i][1], hi[i][2], hi[i][3]};
        o[i % NDB] = MFMA32(pa[i / NDB], vf, o[i % NDB]);
        __builtin_amdgcn_sched_barrier(0);
    }
#undef VADDR
}
template <int MODE> __device__ __forceinline__ void row_pass(const LAS float* E, int tid, size_t grow0, int col0, const bf16* G, bf16* O, const float* subg, float post) {
    const int row = tid >> 2, seg = tid & 3; const LAS float* e = E + row * 132 + 32 * seg;
    float v[32];
#pragma unroll
    for (int i = 0; i < 8; ++i) { const f32x4 x = *(const LAS f32x4*)(e + 4 * i); v[4 * i] = x[0]; v[4 * i + 1] = x[1]; v[4 * i + 2] = x[2]; v[4 * i + 3] = x[3]; }
    if (MODE == 1) { float ss = 0.f;
#pragma unroll
        for (int i = 0; i < 32; ++i) ss += v[i] * v[i];
        ss += __shfl_xor(ss, 1); ss += __shfl_xor(ss, 2);
        const float rstd = 1.0f / sqrtf(ss * (1.0f / 128.0f) + EPS);
#pragma unroll
        for (int i = 0; i < 32; ++i) v[i] *= rstd; }
    const size_t off = (grow0 + row) * DM + col0 + 32 * seg;
#pragma unroll
    for (int i = 0; i < 4; ++i) { const u32x4 g = *(const u32x4*)(G + off + 8 * i); u32x4 w;
#pragma unroll
        for (int j = 0; j < 4; ++j) { const float lo = v[8 * i + 2 * j] * __uint_as_float(g[j] << 16), hi = v[8 * i + 2 * j + 1] * __uint_as_float(g[j] & 0xffff0000u); w[j] = cvtpk(lo, hi); }
        *(u32x4*)(O + off + 8 * i) = w; }
}

#define XB_TMO      128
#define XB_XCNT(j)  (256  + 64 * (j))
#define XB_XSUB(j)  (1280 + 64 * (j))
#define XB_XGEN(j)  (2304 + 64 * (j))
#define XB_TOP      3328
#define XB_TOPGEN   3392
#define XCD_BAR_WORDS 3456
#define XB_SPIN_CAP (1u << 18)

__device__ __forceinline__ unsigned xb_ld(unsigned* p)              { return __hip_atomic_load(p, __ATOMIC_RELAXED, __HIP_MEMORY_SCOPE_AGENT); }
__device__ __forceinline__ unsigned xb_add(unsigned* p, unsigned v) { return __hip_atomic_fetch_add(p, v, __ATOMIC_RELAXED, __HIP_MEMORY_SCOPE_AGENT); }
__device__ __forceinline__ unsigned xb_xcc_id() { return (unsigned)__builtin_amdgcn_s_getreg((3 << 11) | 20) & 0xFu; }
#define XB_SPIN(cond, bar) do { unsigned _sp = 0; while (cond) { __builtin_amdgcn_s_sleep(1); \
    if ((++_sp & 255u) == 0u) { if (xb_ld(&(bar)[XB_TMO])) break; if (_sp > XB_SPIN_CAP) { atomicAdd(&(bar)[XB_TMO], 1u); break; } } } } while (0)

struct XcdBarrier {
    unsigned* bar; unsigned x;
    volatile LAS unsigned* st;
};

__device__ __forceinline__ XcdBarrier xcd_barrier_post(unsigned* bar, volatile LAS unsigned* st) {
    XcdBarrier b; b.bar = bar; b.x = xb_xcc_id(); b.st = st;
    if (threadIdx.x == 0) (void)xb_add(&bar[XB_XCNT(b.x)], 1u);
    return b;
}
__device__ __forceinline__ void xcd_barrier_complete(unsigned* bar, unsigned x, unsigned& nloc, unsigned& nx) {
    const unsigned G = gridDim.x * gridDim.y * gridDim.z;
    unsigned sum, cnt, mine, sp = 0u;
    for (;;) {
        sum = 0u; cnt = 0u; mine = 0u;
#pragma unroll
        for (unsigned j = 0; j < 16; ++j) { const unsigned c = xb_ld(&bar[XB_XCNT(j)]); sum += c; cnt += (c > 0u) ? 1u : 0u; mine = (j == x) ? c : mine; }
        if (sum == G) break;
        __builtin_amdgcn_s_sleep(1);
        if ((++sp & 255u) == 0u) { if (xb_ld(&bar[XB_TMO])) break; if (sp > XB_SPIN_CAP) { atomicAdd(&bar[XB_TMO], 1u); break; } }
    }
    nloc = mine > 0u ? mine : 1u; nx = cnt > 0u ? cnt : 1u;
}

__device__ __forceinline__ void xcd_barrier(const XcdBarrier& b) {
    asm volatile("s_waitcnt vmcnt(0)" ::: "memory");
    __syncthreads();
    if (threadIdx.x == 0) {
        unsigned* bar = b.bar;
        __builtin_amdgcn_s_waitcnt(0);
        unsigned nloc = b.st[0], nx = b.st[1];
        if (nloc == 0u) { xcd_barrier_complete(bar, b.x, nloc, nx); b.st[0] = nloc; b.st[1] = nx; }
        const unsigned old = xb_add(&bar[XB_XSUB(b.x)], 1u);
        const unsigned gen = old / nloc;
        if (old + 1u == (gen + 1u) * nloc) {
            __builtin_amdgcn_fence(__ATOMIC_RELEASE, "agent");
            asm volatile("s_waitcnt vmcnt(0)" ::: "memory");
            const unsigned og = xb_add(&bar[XB_TOP], 1u);
            const unsigned tg = og / nx;
            if (og + 1u == (tg + 1u) * nx) xb_add(&bar[XB_TOPGEN], 1u);
            else XB_SPIN(xb_ld(&bar[XB_TOPGEN]) == tg, bar);
            __builtin_amdgcn_fence(__ATOMIC_ACQUIRE, "agent");
            xb_add(&bar[XB_XGEN(b.x)], 1u);
            asm volatile("s_waitcnt vmcnt(0)" ::: "memory");
        } else {
            XB_SPIN(xb_ld(&bar[XB_XGEN(b.x)]) == gen, bar);
            __builtin_amdgcn_fence(__ATOMIC_ACQUIRE, "agent");
            asm volatile("s_waitcnt vmcnt(0)" ::: "memory");
        }
    }
    __syncthreads();
}

__device__ __forceinline__ void stick_attn_phase(LAS unsigned char* lds, int vcu, int G, const bf16* Qt, const bf16* Kt, const bf16* Vt, const bf16* Gt, bf16* Ot) {
    int tid_ = threadIdx.x; asm volatile("" : "+v"(tid_)); const int tid = tid_, lane = tid & 63, w = __builtin_amdgcn_readfirstlane(tid >> 6), r32 = lane & 31, hi = lane >> 5;
    const int c = w >> 2, jw = w & 3;
    const KVMap map = kv_map(w, lane);
    const LAS unsigned char* kfb = lds + c * 8448 + hi * 1056 + r32 * 16;
    const LAS unsigned char* vfb = lds + 17408 + (2 * c) * 4160 + (4 * hi + ((lane & 15) >> 2)) * 64 + ((lane >> 4) & 1) * 32 + (lane & 3) * 8;
    LAS float* E = (LAS float*)lds;
    volatile LAS float* flags = (volatile LAS float*)(lds + ATT_FLAGS);
    for (int u = vcu; u < 1024; u += G) {
        const int bhp = u >> 6, qb = u & 63, b = bhp >> 3, hp = bhp & 7;
        const size_t rowbase = (size_t)b * SEQ; const int q0 = qb * 128, q0w = q0 + 32 * jw, qrow = q0w + r32, col0 = hp * 128;
        const int tmax = 2 * qb + 1, tw = (q0w + 30) >> 6;
        bf16x8 qr[4];
#pragma unroll
        for (int d0 = 0; d0 < 4; ++d0) qr[d0] = *(const bf16x8*)(Qt + (rowbase + qrow) * DM + col0 + c * 64 + d0 * 16 + hi * 8);
        f32x16 o[2];
#pragma unroll
        for (int r = 0; r < 16; ++r) { o[0][r] = 0.f; o[1][r] = 0.f; }
        float crun = 1.0f; bool active = true;
        KVStage st;
        kv_gload(st, Kt + (rowbase + 64 * tmax) * DM + col0, Vt + (rowbase + 64 * tmax) * DM + col0, map);
        kv_lstore(st, lds, map);
        __builtin_amdgcn_s_waitcnt(0);
        __syncthreads();
        int it = 0;
        for (int t = tmax; t >= 0; --t, ++it) {
            const int cur = it & 1;
            if (t > 0) kv_gload(st, Kt + (rowbase + 64 * (t - 1)) * DM + col0, Vt + (rowbase + 64 * (t - 1)) * DM + col0, map);
            if (active && t <= tw) {
                f32x16 p0, p1, l0, l1;
                qk_tile(p0, p1, kfb + cur * 34048, qr, 0.f);
                const bool need_mask = (64 * t + 63 >= q0w);
                const int kv0 = 64 * t;
#pragma unroll
                for (int r = 0; r < 16; ++r) {
                    { const float z = p0[r], e = __builtin_amdgcn_exp2f(-fabsf(z)), rr = __builtin_amdgcn_rcpf(1.0f + e), er = e * rr; float nb = (z >= 0.f) ? er : rr, bb = (z >= 0.f) ? rr : er;
                      if (need_mask && (kv0 + crow(r, hi) >= qrow)) { nb = 1.f; bb = 0.f; } l0[r] = nb; p0[r] = bb; }
                    { const float z = p1[r], e = __builtin_amdgcn_exp2f(-fabsf(z)), rr = __builtin_amdgcn_rcpf(1.0f + e), er = e * rr; float nb = (z >= 0.f) ? er : rr, bb = (z >= 0.f) ? rr : er;
                      if (need_mask && (kv0 + 32 + crow(r, hi) >= qrow)) { nb = 1.f; bb = 0.f; } l1[r] = nb; p1[r] = bb; }
                }
                float S[16];
#pragma unroll
                for (int g = 0; g < 4; ++g) {
                    const float s0 = (l0[4 * g] * l0[4 * g + 1]) * (l0[4 * g + 2] * l0[4 * g + 3]);
                    const float s1 = (l1[4 * g] * l1[4 * g + 1]) * (l1[4 * g + 2] * l1[4 * g + 3]);
                    auto ra = __builtin_amdgcn_permlane32_swap(__float_as_uint(s0), __float_as_uint(s0), false, false);
                    auto rb = __builtin_amdgcn_permlane32_swap(__float_as_uint(s1), __float_as_uint(s1), false, false);
                    S[2 * g] = __uint_as_float(ra[0]); S[2 * g + 1] = __uint_as_float(ra[1]); S[8 + 2 * g] = __uint_as_float(rb[0]); S[8 + 2 * g + 1] = __uint_as_float(rb[1]);
                }
                float suf[16]; suf[15] = crun;
#pragma unroll
                for (int g = 14; g >= 0; --g) suf[g] = suf[g + 1] * S[g + 1];
                crun = suf[0] * S[0];
#pragma unroll
                for (int g = 0; g < 4; ++g) {
                    { const float e3 = hi ? suf[2 * g + 1] : suf[2 * g], e2 = e3 * l0[4 * g + 3], e1 = e2 * l0[4 * g + 2], e0 = e1 * l0[4 * g + 1];
                      p0[4 * g] *= e0; p0[4 * g + 1] *= e1; p0[4 * g + 2] *= e2; p0[4 * g + 3] *= e3; }
                    { const float e3 = hi ? suf[8 + 2 * g + 1] : suf[8 + 2 * g], e2 = e3 * l1[4 * g + 3], e1 = e2 * l1[4 * g + 2], e0 = e1 * l1[4 * g + 1];
                      p1[4 * g] *= e0; p1[4 * g + 1] *= e1; p1[4 * g + 2] *= e2; p1[4 * g + 3] *= e3; }
                }
                pv_tile<2>(o, vfb + cur * 34048, p0, p1);
                float mx = crun;
#pragma unroll
                for (int off = 1; off < 32; off <<= 1) mx = fmaxf(mx, __shfl_xor(mx, off));
                if (mx <= SB_MASS) active = false;
            }
            if (lane == 0) flags[cur * 8 + w] = active ? 0.f : 1.f;
            if (t > 0) kv_lstore(st, lds + (cur ^ 1) * 34048, map);
            __syncthreads();
            float fs = 0.f;
#pragma unroll
            for (int i = 0; i < 8; ++i) fs += flags[cur * 8 + i];
            if (fs >= 7.5f) break;
        }
#pragma unroll
        for (int db = 0; db < 2; ++db)
#pragma unroll
            for (int r = 0; r < 16; ++r) E[(32 * jw + crow(r, hi)) * 132 + 64 * c + 32 * db + r32] = o[db][r];
        __syncthreads();
        row_pass<0>(E, tid, rowbase + q0, col0, Gt, Ot, nullptr, 1.f);
        __syncthreads();
    }
}

#define DSB() __builtin_amdgcn_sched_barrier(0)
#define EXP4_ASM(P, R, S0, S1) asm volatile("v_exp_f32_e32 %0, %0\n\tv_exp_f32_e32 %1, %1\n\tv_exp_f32_e32 %2, %2\n\tv_exp_f32_e32 %3, %3\n\t" \
    "v_add_f32_e32 %4, %4, %0\n\tv_add_f32_e32 %5, %5, %1\n\tv_add_f32_e32 %4, %4, %2\n\tv_add_f32_e32 %5, %5, %3" \
    : "+v"(P[R]), "+v"(P[R + 1]), "+v"(P[R + 2]), "+v"(P[R + 3]), "+v"(S0), "+v"(S1))
#define EXP4_FIRST(P, S0, S1) do { P[0] = __builtin_amdgcn_exp2f(P[0]); P[1] = __builtin_amdgcn_exp2f(P[1]); P[2] = __builtin_amdgcn_exp2f(P[2]); P[3] = __builtin_amdgcn_exp2f(P[3]); \
    S0 = P[0] + P[2]; S1 = P[1] + P[3]; } while (0)
__device__ __forceinline__ void diff_tile(f32x16 (&o)[4], float& lsum, const LAS unsigned char* kb, const LAS unsigned char* vb, const bf16x8 (&qr)[4], float negm, bool need_mask, int lim) {
    f32x16 p0, p1;
#pragma unroll
    for (int r = 0; r < 16; ++r) { p0[r] = negm; p1[r] = negm; }
    bf16x8 kf[8];
#define KADDR(i) (kb + ((i) & 3) * 2112 + ((i) >> 2) * 512)
#define VADDR(i) (vb + ((i) & 3) * 4160 + ((i) >> 2) * 1024)
    kf[0] = *(const LAS bf16x8*)KADDR(0); kf[1] = *(const LAS bf16x8*)KADDR(1); kf[2] = *(const LAS bf16x8*)KADDR(2);
    DSB();
#pragma unroll
    for (int i = 0; i < 4; ++i) { kf[i + 3] = *(const LAS bf16x8*)KADDR(i + 3); p0 = MFMA32(kf[i], qr[i], p0); DSB(); }
    float s0, s1, s2, s3;
    s16x4 lo[16], hh[16];
    kf[7] = *(const LAS bf16x8*)KADDR(7); p1 = MFMA32(kf[4], qr[0], p1);
    if (need_mask) {
#pragma unroll
        for (int r = 0; r < 16; ++r) if ((r & 3) + 8 * (r >> 2) > lim) p0[r] = -INFINITY; }
    EXP4_FIRST(p0, s0, s1); DSB();
    p1 = MFMA32(kf[5], qr[1], p1); EXP4_ASM(p0, 4, s0, s1); DSB();
    p1 = MFMA32(kf[6], qr[2], p1); EXP4_ASM(p0, 8, s0, s1); lo[0] = vtr(VADDR(0)); hh[0] = vtr(VADDR(0) + 512); DSB();
    p1 = MFMA32(kf[7], qr[3], p1); EXP4_ASM(p0, 12, s0, s1); lo[1] = vtr(VADDR(1)); hh[1] = vtr(VADDR(1) + 512); DSB();
    bf16x8 pa[4];
    { u32x4 w;
      w = (u32x4){cvtpk(p0[0], p0[1]), cvtpk(p0[2], p0[3]), cvtpk(p0[4], p0[5]), cvtpk(p0[6], p0[7])}; pa[0] = __builtin_bit_cast(bf16x8, w);
      w = (u32x4){cvtpk(p0[8], p0[9]), cvtpk(p0[10], p0[11]), cvtpk(p0[12], p0[13]), cvtpk(p0[14], p0[15])}; pa[1] = __builtin_bit_cast(bf16x8, w); }
    lo[2] = vtr(VADDR(2)); hh[2] = vtr(VADDR(2) + 512);
    DSB();
#define PVSTEP(i) do { if ((i) + 3 < 16) { lo[(i) + 3] = vtr(VADDR((i) + 3)); hh[(i) + 3] = vtr(VADDR((i) + 3) + 512); } \
        { const bf16x8 vf_ = {lo[i][0], lo[i][1], lo[i][2], lo[i][3], hh[i][0], hh[i][1], hh[i][2], hh[i][3]}; o[(i) & 3] = MFMA32(pa[(i) >> 2], vf_, o[(i) & 3]); } } while (0)
    PVSTEP(0);
    if (need_mask) {
#pragma unroll
        for (int r = 0; r < 16; ++r) if (32 + (r & 3) + 8 * (r >> 2) > lim) p1[r] = -INFINITY; }
    EXP4_FIRST(p1, s2, s3); DSB();
    PVSTEP(1); DSB();
    PVSTEP(2); EXP4_ASM(p1, 4, s2, s3); DSB();
    PVSTEP(3); DSB();
    PVSTEP(4); EXP4_ASM(p1, 8, s2, s3); DSB();
    PVSTEP(5); DSB();
    PVSTEP(6); EXP4_ASM(p1, 12, s2, s3); DSB();
    PVSTEP(7);
    { u32x4 w;
      w = (u32x4){cvtpk(p1[0], p1[1]), cvtpk(p1[2], p1[3]), cvtpk(p1[4], p1[5]), cvtpk(p1[6], p1[7])}; pa[2] = __builtin_bit_cast(bf16x8, w);
      w = (u32x4){cvtpk(p1[8], p1[9]), cvtpk(p1[10], p1[11]), cvtpk(p1[12], p1[13]), cvtpk(p1[14], p1[15])}; pa[3] = __builtin_bit_cast(bf16x8, w); }
    DSB();
#pragma unroll
    for (int i = 8; i < 16; ++i) { PVSTEP(i); DSB(); }
    lsum += (s0 + s1) + (s2 + s3);
#undef PVSTEP
#undef KADDR
#undef VADDR
}
__device__ __forceinline__ void diff_attn_phase(LAS unsigned char* lds, int vcu, int G, const bf16* Qt, const bf16* Kt, const bf16* Vt, const bf16* Gt, bf16* Ot,
                                                const float* qg, const float* kg, const float* lamp, const float* subg) {
    int tid_ = threadIdx.x; asm volatile("" : "+v"(tid_)); const int tid = tid_, lane = tid & 63, w = __builtin_amdgcn_readfirstlane(tid >> 6), r32 = lane & 31, hi = lane >> 5;
    const int c = w >> 2, jw = w & 3;
    float lam, post, negm;
    { float a = lamp[lane] * lamp[64 + lane], bb = lamp[128 + lane] * lamp[192 + lane]; a = wave_sum(a); bb = wave_sum(bb);
      const float lam_init = 0.8f - 0.6f * expf(-0.3f); lam = expf(a) - expf(bb) + lam_init; post = 1.0f - lam_init;
      const float gq = wave_max(fabsf(qg[lane])), gk = wave_max(fabsf(kg[lane])); negm = -(8.0f * gq * gk * LOG2E); }
    const KVMap map = kv_map(w, lane);
    const LAS unsigned char* kfb = lds + c * 8448 + hi * 1056 + r32 * 16;
    const LAS unsigned char* vfb = lds + 17408 + (4 * hi + ((lane & 15) >> 2)) * 64 + ((lane >> 4) & 1) * 32 + (lane & 3) * 8;
    LAS float* E = (LAS float*)lds;
    LAS float* wsf = (LAS float*)(lds + DIFF_WSF) + w * 64;
    for (int pi = vcu; pi < 512; pi += G) {
        const int bh = pi >> 5, jj = pi & 31, b = bh >> 3, h = bh & 7;
        const size_t rowbase = (size_t)b * SEQ; const int col0 = h * 128;
        for (int uu = 0; uu < 2; ++uu) {
            const int qb = uu ? 63 - jj : jj, q0 = qb * 128, q0w = q0 + 32 * jw, qrow = q0w + r32, NTL = 2 * qb + 2;
            bf16x8 qr[4];
#pragma unroll
            for (int d0 = 0; d0 < 4; ++d0) qr[d0] = *(const bf16x8*)(Qt + (rowbase + qrow) * DM + col0 + c * 64 + d0 * 16 + hi * 8);
            f32x16 o[4];
#pragma unroll
            for (int r = 0; r < 16; ++r) { o[0][r] = 0.f; o[1][r] = 0.f; o[2][r] = 0.f; o[3][r] = 0.f; }
            float lsum = 0.f;
            KVStage st;
            kv_gload(st, Kt + rowbase * DM + col0, Vt + rowbase * DM + col0, map);
            kv_lstore(st, lds, map);
            kv_gload(st, Kt + (rowbase + 64) * DM + col0, Vt + (rowbase + 64) * DM + col0, map);
            kv_lstore(st, lds + 34048, map);
            __builtin_amdgcn_s_waitcnt(0);
            __syncthreads();
            const int NS = NTL >> 1;
            for (int u = 0; u < NS; ++u) {
                const int cb = (u & 1) * 68096, nb = cb ^ 68096; const bool more = (u + 1 < NS);
                if (more) kv_gload(st, Kt + (rowbase + 64 * (2 * u + 2)) * DM + col0, Vt + (rowbase + 64 * (2 * u + 2)) * DM + col0, map);
#pragma unroll
                for (int j = 0; j < 2; ++j) {
                    const int t = 2 * u + j;
                    if (64 * t <= q0w + 31) { int lim = qrow - 64 * t - 4 * hi; asm volatile("" : "+v"(lim));
                        diff_tile(o, lsum, kfb + cb + j * 34048, vfb + cb + j * 34048, qr, negm, 64 * t + 63 > q0w, lim); }
                    if (more) { kv_lstore(st, lds + nb + j * 34048, map);
                        if (j == 0) kv_gload(st, Kt + (rowbase + 64 * (2 * u + 3)) * DM + col0, Vt + (rowbase + 64 * (2 * u + 3)) * DM + col0, map); }
                }
                __syncthreads();
            }
            { auto rr = __builtin_amdgcn_permlane32_swap(__float_as_uint(lsum), __float_as_uint(lsum), false, false); lsum = __uint_as_float(rr[0]) + __uint_as_float(rr[1]); }
            if (hi == 0) wsf[r32] = (c ? lam : 1.0f) / lsum;
            float rli[16];
#pragma unroll
            for (int r = 0; r < 16; ++r) rli[r] = wsf[crow(r, hi)];
            if (c == 1) {
#pragma unroll
                for (int db = 0; db < 4; ++db)
#pragma unroll
                    for (int r = 0; r < 16; ++r) E[(32 * jw + crow(r, hi)) * 132 + 32 * db + r32] = o[db][r] * rli[r];
            }
            __syncthreads();
            if (c == 0) {
#pragma unroll
                for (int db = 0; db < 4; ++db)
#pragma unroll
                    for (int r = 0; r < 16; ++r) { LAS float* e = E + (32 * jw + crow(r, hi)) * 132 + 32 * db + r32; *e = o[db][r] * rli[r] - *e; }
            }
            __syncthreads();
            row_pass<1>(E, tid, rowbase + q0, col0, Gt, Ot, subg, post);
            __syncthreads();
        }
    }
}

__device__ __forceinline__ unsigned f2bf(float f) { unsigned u = __builtin_bit_cast(unsigned, f); return (u + 0x7fffu + ((u >> 16) & 1u)) >> 16; }
__device__ __forceinline__ unsigned pk2(float lo, float hi) { return f2bf(lo) | (f2bf(hi) << 16); }
__device__ __forceinline__ void p0_transpose_item(const float* W, const float* g, int K, int N, bf16* WT, int row_off, LAS float* scr, int item, int lane, int perm_below = 0) {
    const int nblk = N / 32, kb = item / nblk, nb = item % nblk, k0 = 64 * kb, n0 = 32 * nb;
    const int np0 = (n0 < perm_below) ? ((n0 & ~255) + 128 * ((n0 >> 5) & 1) + 32 * ((n0 & 255) >> 6)) : n0;
    float wv[32];
#pragma unroll
    for (int i = 0; i < 32; ++i) { const int kk = 2 * i + (lane >> 5); const float gv = g ? g[k0 + kk] : 1.0f; wv[i] = W[(size_t)(k0 + kk) * N + n0 + (lane & 31)] * gv; }
#pragma unroll
    for (int i = 0; i < 32; ++i) { const int kk = 2 * i + (lane >> 5); scr[kk * 33 + (lane & 31)] = wv[i]; }
    asm volatile("s_waitcnt lgkmcnt(0)" ::: "memory");
    const int cc = lane & 7;
#pragma unroll
    for (int j = 0; j < 4; ++j) { const int n = (lane >> 3) + 8 * j; const LAS float* s = scr + (8 * cc) * 33 + n;
        u32x4 o; o.x = pk2(s[0 * 33], s[1 * 33]); o.y = pk2(s[2 * 33], s[3 * 33]); o.z = pk2(s[4 * 33], s[5 * 33]); o.w = pk2(s[6 * 33], s[7 * 33]);
        *(u32x4*)(WT + (size_t)(row_off + np0 + n) * K + k0 + 8 * cc) = o; }
    asm volatile("s_waitcnt lgkmcnt(0)" ::: "memory");
}
__device__ __forceinline__ void rms_row_to_bf16(const float* xrow, bf16* orow, int lane) {
    const f32x4* xr = (const f32x4*)xrow + lane;
    f32x4 v[4]; float s = 0.f;
#pragma unroll
    for (int j = 0; j < 4; ++j) { v[j] = xr[64 * j]; s += (v[j].x * v[j].x + v[j].y * v[j].y) + (v[j].z * v[j].z + v[j].w * v[j].w); }
    const float rstd = 1.0f / sqrtf(wave_sum(s) * (1.0f / DM) + EPS);
    unsigned long long* o8 = (unsigned long long*)orow + lane;
#pragma unroll
    for (int j = 0; j < 4; ++j) o8[64 * j] = (unsigned long long)pk2(v[j].x * rstd, v[j].y * rstd) | ((unsigned long long)pk2(v[j].z * rstd, v[j].w * rstd) << 32);
}
__device__ __forceinline__ void qk_norm_rope_item(bf16* Kraw, bf16* Qraw, const float* kg, const float* qg, const f32x2* rope, int idx) {
    const int row = idx >> 5, c32 = idx & 31; const bool isq = c32 >= 16;
    bf16* p = (isq ? Qraw : Kraw) + (size_t)row * DM + (c32 & 15) * 64; const float* g = isq ? qg : kg;
    u32x4 raw[8];
#pragma unroll
    for (int i = 0; i < 8; ++i) raw[i] = *(const u32x4*)(p + 8 * i);
    float v[64]; float ss = 0.f;
#pragma unroll
    for (int i = 0; i < 8; ++i)
#pragma unroll
        for (int j = 0; j < 4; ++j) { const float lo = __uint_as_float(raw[i][j] << 16), hi = __uint_as_float(raw[i][j] & 0xffff0000u); v[8 * i + 2 * j] = lo; v[8 * i + 2 * j + 1] = hi; ss += lo * lo + hi * hi; }
    const float rstd = (isq ? QS : 1.0f) / sqrtf(ss * (1.0f / 64.0f) + EPS);
    const f32x2* cs = rope + (size_t)row * 32;
#pragma unroll
    for (int i = 0; i < 32; ++i) { const f32x2 t = cs[i]; const float t1 = v[i] * rstd * g[i], t2 = v[i + 32] * rstd * g[i + 32]; v[i] = t1 * t.x - t2 * t.y; v[i + 32] = t2 * t.x + t1 * t.y; }
#pragma unroll
    for (int i = 0; i < 8; ++i) { u32x4 o;
#pragma unroll
        for (int j = 0; j < 4; ++j) o[j] = cvtpk(v[8 * i + 2 * j], v[8 * i + 2 * j + 1]);
        *(u32x4*)(p + 8 * i) = o; }
}

struct Args { const float* x; const int* pos; const float* a_norm_g; const float* a_w_in; const float* a_w_out; const float* kv_norm_g; const float* w_kv; const float* k_norm_g;
              const float* b_norm_g; const float* b_w_in; const float* b_q_norm_g; const float* b_lambda; const float* b_subln_g; const float* b_w_out; float* out; unsigned char* ws; int cg_seams; int pad_; };

__global__ void __launch_bounds__(NTHR, 2) yoco_fwd(Args a) {
    extern __shared__ __attribute__((aligned(16))) unsigned char lds_raw[];
    LAS unsigned char* lds = (LAS unsigned char*)lds_raw;
    cg::grid_group grid = cg::this_grid();
    const int tid = threadIdx.x, lane = tid & 63, wave = __builtin_amdgcn_readfirstlane(tid >> 6);
    const int G = gridDim.x, bx = blockIdx.x, vcu = (G % 8 == 0) ? (bx % 8) * (G / 8) + bx / 8 : bx;
    unsigned char* ws = a.ws;
    if (tid < 16) ((LAS unsigned*)(lds + LDS_CTL))[tid] = 0u;
    __syncthreads();
    const XcdBarrier bar = xcd_barrier_post((unsigned*)(ws + WS_BAR), (volatile LAS unsigned*)(lds + LDS_CTL));
    float* sumsq = (float*)(ws + WS_SUMSQ); f32x2* rope = (f32x2*)(ws + WS_ROPE);
    bf16* WinA = (bf16*)(ws + WS_WINA); bf16* WoutA = (bf16*)(ws + WS_WOUTA); bf16* WB = (bf16*)(ws + WS_WB); bf16* WoutB = (bf16*)(ws + WS_WOUTB);
    bf16* XA = (bf16*)(ws + WS_XA); bf16* T0 = (bf16*)(ws + WS_T); bf16* T1 = T0 + TSTRIDE; bf16* T2 = T1 + TSTRIDE; bf16* T3 = T2 + TSTRIDE; bf16* OB = (bf16*)(ws + WS_O);

    {
        LAS float* scr = (LAS float*)(lds + wave * 16384);
        const int gw = vcu * NWAVES + wave, NGW = G * NWAVES;
        constexpr int I_INA = 16 * 128, I_OUT = 16 * 32, I_KV = 16 * 64, I_BIN = 16 * 64;
        constexpr int NITEMS = I_INA + I_OUT + I_KV + I_BIN + I_OUT;
        for (int it = gw; it < NITEMS; it += NGW) {
            int r = it;
            if (r < I_INA) { p0_transpose_item(a.a_w_in, a.a_norm_g, DM, 4096, WinA, 0, scr, r, lane); continue; } r -= I_INA;
            if (r < I_OUT) { p0_transpose_item(a.a_w_out, nullptr, DM, DM, WoutA, 0, scr, r, lane); continue; } r -= I_OUT;
            if (r < I_KV) { p0_transpose_item(a.w_kv, a.kv_norm_g, DM, 2048, WB, 0, scr, r, lane, 1024); continue; } r -= I_KV;
            if (r < I_BIN) { p0_transpose_item(a.b_w_in, a.b_norm_g, DM, 2048, WB, 2048, scr, r, lane, 1024); continue; } r -= I_BIN;
            p0_transpose_item(a.b_w_out, nullptr, DM, DM, WoutB, 0, scr, r, lane);
        }
        for (int m = gw; m < M; m += 2 * NGW) {
            const f32x4* xa0 = (const f32x4*)(a.x + (size_t)m * DM) + lane; const int m1 = (m + NGW < M) ? m + NGW : m; const f32x4* xa1 = (const f32x4*)(a.x + (size_t)m1 * DM) + lane;
            f32x4 v0[4], v1[4]; float q0 = 0.f, q1 = 0.f;
#pragma unroll
            for (int j = 0; j < 4; ++j) { v0[j] = xa0[64 * j]; v1[j] = xa1[64 * j]; }
#pragma unroll
            for (int j = 0; j < 4; ++j) { q0 += (v0[j].x * v0[j].x + v0[j].y * v0[j].y) + (v0[j].z * v0[j].z + v0[j].w * v0[j].w); q1 += (v1[j].x * v1[j].x + v1[j].y * v1[j].y) + (v1[j].z * v1[j].z + v1[j].w * v1[j].w); }
            const float r0 = 1.0f / sqrtf(wave_sum(q0) * (1.0f / DM) + EPS), r1 = 1.0f / sqrtf(wave_sum(q1) * (1.0f / DM) + EPS);
            unsigned long long* o0 = (unsigned long long*)(XA + (size_t)m * DM) + lane; unsigned long long* o1 = (unsigned long long*)(XA + (size_t)m1 * DM) + lane;
#pragma unroll
            for (int j = 0; j < 4; ++j) { o0[64 * j] = (unsigned long long)pk2(v0[j].x * r0, v0[j].y * r0) | ((unsigned long long)pk2(v0[j].z * r0, v0[j].w * r0) << 32);
                o1[64 * j] = (unsigned long long)pk2(v1[j].x * r1, v1[j].y * r1) | ((unsigned long long)pk2(v1[j].z * r1, v1[j].w * r1) << 32); }
        }
        const int gt = vcu * NTHR + tid, NGT = G * NTHR;
        for (int idx = gt; idx < M * 32; idx += NGT) {
            const int row = idx >> 5, i = idx & 31;
            const float inv = (float)exp2(-(double)i * (13.287712379549449 / 32.0));
            const float ang = (float)a.pos[row] * inv;
            const double ad = (double)ang; const double kq = rint(ad * 0.15915494309189535);
            double rr = fma(-kq, 6.283185307179586, ad); rr = fma(-kq, 2.4492935982947064e-16, rr);
            const float rf = (float)rr;
            rope[idx] = (f32x2){cosf(rf), sinf(rf)};
        }
    }
    if (a.cg_seams) grid.sync(); else xcd_barrier(bar);
    { pg8::Gemm g{XA, WinA, M, 4096, DM}; pg8::StaticOrder S; S.init(M, 4096, G, bx);
      pg8::EpiSplit4 E{T0, TSTRIDE, nullptr, QS, 0, 3};
      pg8::gemm_phase<pg8::EpiSplit4, pg8::StaticOrder, true, true>(lds, g, S, E); }
    if (a.cg_seams) grid.sync(); else xcd_barrier(bar);
    stick_attn_phase(lds, vcu, G, T0, T1, T2, T3, OB);
    if (a.cg_seams) grid.sync(); else xcd_barrier(bar);
    { pg8::Gemm g{OB, WoutA, M, DM, DM}; pg8::StaticOrder S; S.init(M, DM, G, bx);
      pg8::EpiRes E{a.x, nullptr, XA, sumsq};
      pg8::gemm_phase<pg8::EpiRes, pg8::StaticOrder, true, true>(lds, g, S, E); }
    if (a.cg_seams) grid.sync(); else xcd_barrier(bar);
    { pg8::Gemm g{XA, WB, M, 4096, DM}; pg8::StaticOrder S; S.init(M, 4096, G, bx);
      pg8::EpiB E{T0, TSTRIDE, sumsq, a.k_norm_g, a.b_q_norm_g, (const float*)rope, QS, a.b_subln_g, 1.0f - (0.8f - 0.6f * expf(-0.3f))};
      pg8::gemm_phase<pg8::EpiB, pg8::StaticOrder, true, true>(lds, g, S, E); }
    if (a.cg_seams) grid.sync(); else xcd_barrier(bar);
    diff_attn_phase(lds, vcu, G, T2, T0, T1, T3, OB, a.b_q_norm_g, a.k_norm_g, a.b_lambda, a.b_subln_g);
    if (a.cg_seams) grid.sync(); else xcd_barrier(bar);
    { pg8::Gemm g{OB, WoutB, M, DM, DM}; pg8::StaticOrder S; S.init(M, DM, G, bx);
      pg8::EpiResBf E{XA, a.out};
      pg8::gemm_phase<pg8::EpiResBf, pg8::StaticOrder, true, true>(lds, g, S, E); }
}
}

extern "C" void kernel_launch(void* const* d_in, const int* in_sizes, int n_in, void* d_out, int out_size, void* d_ws, size_t ws_size, hipStream_t stream) {
    static int grid = 0;
    if (grid == 0) {
        if (n_in != 14 || in_sizes[0] != mk::M * mk::DM || out_size != mk::M * mk::DM || ws_size < mk::WS_END) { fprintf(stderr, "kernel_launch: unexpected shapes (n_in %d, ws %zu); nothing launched\n", n_in, ws_size); grid = -1; return; }
        int dev = 0, cus = 0, per_cu = 0;
        if (hipGetDevice(&dev) != hipSuccess || hipDeviceGetAttribute(&cus, hipDeviceAttributeMultiprocessorCount, dev) != hipSuccess) { grid = -1; return; }
        if (hipFuncSetAttribute((const void*)mk::yoco_fwd, hipFuncAttributeMaxDynamicSharedMemorySize, mk::LDS_BYTES) != hipSuccess) { fprintf(stderr, "kernel_launch: hipFuncSetAttribute failed\n"); grid = -1; return; }
        if (hipOccupancyMaxActiveBlocksPerMultiprocessor(&per_cu, (const void*)mk::yoco_fwd, mk::NTHR, mk::LDS_BYTES) != hipSuccess || per_cu < 1) { fprintf(stderr, "kernel_launch: occupancy query gave %d\n", per_cu); (void)hipGetLastError(); per_cu = 1; }
        grid = cus * per_cu;
    }
    if (grid < 0) return;
    (void)hipMemsetAsync((char*)d_ws, 0, 512 * 1024, stream);
    mk::Args a{};
    a.x = (const float*)d_in[0]; a.pos = (const int*)d_in[1]; a.a_norm_g = (const float*)d_in[2]; a.a_w_in = (const float*)d_in[3]; a.a_w_out = (const float*)d_in[4];
    a.kv_norm_g = (const float*)d_in[5]; a.w_kv = (const float*)d_in[6]; a.k_norm_g = (const float*)d_in[7]; a.b_norm_g = (const float*)d_in[8]; a.b_w_in = (const float*)d_in[9];
    a.b_q_norm_g = (const float*)d_in[10]; a.b_lambda = (const float*)d_in[11]; a.b_subln_g = (const float*)d_in[12]; a.b_w_out = (const float*)d_in[13];
    a.out = (float*)d_out; a.ws = (unsigned char*)d_ws;
    void* args[] = {&a};
    const hipError_t e = hipLaunchCooperativeKernel((const void*)mk::yoco_fwd, dim3(grid), dim3(mk::NTHR), args, mk::LDS_BYTES, stream);
    if (e != hipSuccess) fprintf(stderr, "kernel_launch: cooperative launch failed: %s (grid %d)\n", hipGetErrorString(e), grid);
}
```

```cpp
#include <hip/hip_runtime.h>
#include <hip/hip_cooperative_groups.h>
#include <cstdio>
#include <cstdint>
#include <cmath>
namespace cg = cooperative_groups;
namespace pg8 {
#define PG8_LAS __attribute__((address_space(3)))
typedef unsigned short bf16_t;
typedef short bf16x8 __attribute__((ext_vector_type(8)));
typedef float f32x4 __attribute__((ext_vector_type(4)));
typedef unsigned u32x4 __attribute__((ext_vector_type(4)));
constexpr int BM = 256, BK = 64, HALF = 128, HTB = HALF * BK * 2  , STAGE_BYTES = 8 * HTB, NXCD = 8, WGM = 8;

__host__ __device__ __forceinline__ int lds_byte(int r, int c) { const int st = (r >> 4) * 2 + (c >> 5), rr = r & 15, cc = c & 31, ob = rr * 64 + cc * 2; return st * 1024 + (ob ^ (((ob >> 9) & 1) << 5)); }
__host__ __device__ __forceinline__ void stage_rc(int b, int& R, int& C) { const int st = b / 1024, sb = b % 1024, swz = sb ^ (((sb >> 9) & 1) << 5); R = (st >> 1) * 16 + swz / 64; C = (st & 1) * 32 + (swz % 64) / 2; }
__host__ __device__ __forceinline__ int perm32(int rho) { const int n = rho >> 4, i = rho & 15; return 8 * (i >> 2) + 4 * n + (i & 3); }

struct Unit { int pm, pn; };
struct Gemm { const bf16_t* A; const bf16_t* Bt; int M, N, K; };

struct StaticOrder {
    int nM, nN, nwg, G, c;
    __host__ __device__ void init(int M, int N, int G_, int c_) { nM = M / BM; nN = N / BM; nwg = nM * nN; G = G_; c = c_; }
    __host__ __device__ bool next(int i, Unit& u) const {
        const long L = (long)i * G + c; if (L >= nwg) return false;
        int wgid = (int)L; { const int q = nwg / NXCD, r = nwg % NXCD, xcd = wgid % NXCD, off = wgid / NXCD; wgid = (xcd < r ? xcd * (q + 1) : r * (q + 1) + (xcd - r) * q) + off; }
        const int nig = WGM * nN, gid = wgid / nig, fm = gid * WGM, gsz = (nM - fm) < WGM ? (nM - fm) : WGM;
        u.pm = fm + ((wgid % nig) % gsz); u.pn = (wgid % nig) / gsz; return true;
    }
    __device__ __forceinline__ void a_ready(const Unit&) const {}
    __device__ __forceinline__ void done(const Unit&) const {}
};

__device__ __forceinline__ unsigned cvt_pk_bf16(float lo, float hi) { unsigned r; asm volatile("v_cvt_pk_bf16_f32 %0, %1, %2" : "=v"(r) : "v"(lo), "v"(hi)); return r; }
typedef float f32x2 __attribute__((ext_vector_type(2)));
__device__ __forceinline__ f32x2 gelu_pk(f32x2 v) {
    const f32x2 av = __builtin_elementwise_abs(v), d = av * 0.2316418882f + 1.0f;
    f32x2 t; t.x = __builtin_amdgcn_rcpf(d.x); t.y = __builtin_amdgcn_rcpf(d.y);
    f32x2 q = t * 0.5307027145f + (-0.7265760135f); q = q * t + 0.7107068705f; q = q * t + (-0.142248368f); q = q * t + 0.127414796f; q = q * t;
    const f32x2 s = (v * v) * (-0.72134752044f);
    f32x2 e; e.x = __builtin_amdgcn_exp2f(s.x); e.y = __builtin_amdgcn_exp2f(s.y);
    const f32x2 m = v * (q * e), r = v - m;
    f32x2 o; o.x = v.x < 0.f ? m.x : r.x; o.y = v.y < 0.f ? m.y : r.y; return o;
}

template <int ACT  > struct EpiBf16 {
    static constexpr bool PERM = true, AFTER_DRAIN = false; static_assert(ACT == 0 || ACT == 1, "EpiBf16: ACT is 0 (none) or 1 (gelu_pk)");
    bf16_t* O; int ldc; const float* bias; int split_cols; size_t split_stride; float scale0;
    __device__ __forceinline__ void operator()(const f32x4 (&acc)[2][2][4][2], const Unit& u, int wr, int wc, int fr, int fq) const {
        const int row0 = u.pm * BM + wr * 64 + fr; int colt = u.pn * BM; bf16_t* base = O;
        float sc = 1.f; if (split_cols) { const int t = colt / split_cols; base += (size_t)t * split_stride; colt -= t * split_cols; if (t == 0) sc = scale0; }
        const int col0 = colt + wc * 32 + 8 * fq, bcol0 = u.pn * BM + wc * 32 + 8 * fq;
        f32x4 bv[2][2];
#pragma unroll
        for (int bj = 0; bj < 2; ++bj)
#pragma unroll
            for (int n = 0; n < 2; ++n) bv[bj][n] = bias ? *(const f32x4*)(bias + bcol0 + bj * HALF + 4 * n) : (f32x4){0.f, 0.f, 0.f, 0.f};
#pragma unroll
        for (int ai = 0; ai < 2; ++ai)
#pragma unroll
            for (int m = 0; m < 4; ++m) { bf16_t* rowp = base + (size_t)(row0 + ai * HALF + m * 16) * ldc + col0;
#pragma unroll
                for (int bj = 0; bj < 2; ++bj) { f32x4 v0 = acc[ai][bj][m][0] + bv[bj][0], v1 = acc[ai][bj][m][1] + bv[bj][1];
                    if (ACT == 1) { f32x2 a = gelu_pk((f32x2){v0[0], v0[1]}), b = gelu_pk((f32x2){v0[2], v0[3]}), c = gelu_pk((f32x2){v1[0], v1[1]}), d = gelu_pk((f32x2){v1[2], v1[3]});
                        v0 = (f32x4){a.x, a.y, b.x, b.y}; v1 = (f32x4){c.x, c.y, d.x, d.y}; }
                    v0 = v0 * sc; v1 = v1 * sc; u32x4 w; w.x = cvt_pk_bf16(v0[0], v0[1]); w.y = cvt_pk_bf16(v0[2], v0[3]); w.z = cvt_pk_bf16(v1[0], v1[1]); w.w = cvt_pk_bf16(v1[2], v1[3]);
                    *(u32x4*)(rowp + bj * HALF) = w; } }
    }
};
template <class Epi, class Sched, bool ALIGN_EPI = false, bool SP2 = false>
__device__ __forceinline__ void gemm_phase(PG8_LAS unsigned char* lds, const Gemm g, const Sched& S, const Epi& E) {
    int tid_ = threadIdx.x; asm volatile("" : "+v"(tid_)); const int tid = tid_, wid = __builtin_amdgcn_readfirstlane(tid >> 6), lane = tid & 63, wr = wid >> 2, wc = wid & 3, fr = lane & 15, fq = lane >> 4;
    const int K = g.K, nt = K / BK;
    unsigned voffA[2], voffB[2];
#pragma unroll
    for (int i = 0; i < 2; ++i) { int R, C; stage_rc(tid * 16 + i * 8192, R, C); const int Rb = Epi::PERM ? ((R & ~31) + perm32(R & 31)) : R;
        voffA[i] = (unsigned)(R * K + C) * 2u; voffB[i] = (unsigned)(Rb * K + C) * 2u; }
    const size_t kstep = (size_t)(BK * 2);
    const size_t hstep = (size_t)HALF * K * 2;
    const size_t tstep = 2 * hstep;
    const unsigned ldsw = (unsigned)wid * 1024u;
    const int aoff = lds_byte(wr * 64 + fr, fq * 8), boff = lds_byte(wc * 32 + fr, fq * 8);
#define PG8_SA(b, h) (((b) * 2 + (h)) * HTB)
#define PG8_SB(b, h) ((4 + (b) * 2 + (h)) * HTB)
#define PG8_STAGE(bufoff, gbase, voff) do { _Pragma("unroll") for (int _i = 0; _i < 2; ++_i) \
        __builtin_amdgcn_global_load_lds((const unsigned*)((const char*)(gbase) + (voff)[_i]), (PG8_LAS unsigned*)(lds + (bufoff) + ldsw + _i * 8192), 16, 0, 0); } while (0)
#define PG8_LDA(dst, b, h) do { _Pragma("unroll") for (int m = 0; m < 4; ++m) _Pragma("unroll") for (int k = 0; k < 2; ++k) dst[m][k] = *(const PG8_LAS bf16x8*)(lds + PG8_SA(b, h) + aoff + m * 2048 + k * 1024); } while (0)
#define PG8_LDB(dst, b, h) do { _Pragma("unroll") for (int n = 0; n < 2; ++n) _Pragma("unroll") for (int k = 0; k < 2; ++k) dst[n][k] = *(const PG8_LAS bf16x8*)(lds + PG8_SB(b, h) + boff + n * 2048 + k * 1024); } while (0)
#define PG8_MMA(ai, bj, At, Bt) do { __builtin_amdgcn_s_setprio(1); _Pragma("unroll") for (int m = 0; m < 4; ++m) _Pragma("unroll") for (int n = 0; n < 2; ++n) _Pragma("unroll") for (int k = 0; k < 2; ++k) \
        acc[ai][bj][m][n] = __builtin_amdgcn_mfma_f32_16x16x32_bf16(Bt[n][k], At[m][k], acc[ai][bj][m][n], 0, 0, 0); __builtin_amdgcn_s_setprio(0); } while (0)
#define PG8_WAIT_V(n) asm volatile("s_waitcnt vmcnt(" #n ")" ::: "memory")
#define PG8_WAIT_L(n) asm volatile("s_waitcnt lgkmcnt(" #n ")" ::: "memory")
#define PG8_BAR __builtin_amdgcn_s_barrier()
#define PG8_SCHED __builtin_amdgcn_sched_barrier(0)
    Unit cur, nxt; int ui = 0;
    if (!S.next(0, cur)) return;
    f32x4 acc[2][2][4][2];
#pragma unroll
    for (int a = 0; a < 2; ++a)
#pragma unroll
        for (int b = 0; b < 2; ++b)
#pragma unroll
            for (int m = 0; m < 4; ++m)
#pragma unroll
                for (int n = 0; n < 2; ++n) acc[a][b][m][n] = (f32x4){0.f, 0.f, 0.f, 0.f};
    bf16x8 At[4][2], B0[2][2], B1[2][2];
    const char* cA = (const char*)g.A + (size_t)cur.pm * tstep; const char* cB = (const char*)g.Bt + (size_t)cur.pn * tstep;
    S.a_ready(cur);
    if constexpr (SP2) {
        PG8_STAGE(PG8_SB(0, 0), cB, voffB); PG8_STAGE(PG8_SB(0, 1), cB + hstep, voffB); PG8_STAGE(PG8_SA(0, 0), cA, voffA); PG8_STAGE(PG8_SA(0, 1), cA + hstep, voffA);
        if (wr == 1) PG8_BAR;
        PG8_WAIT_V(2); PG8_BAR;
        PG8_STAGE(PG8_SB(1, 0), cB + kstep, voffB); PG8_STAGE(PG8_SA(1, 0), cA + kstep, voffA); PG8_STAGE(PG8_SB(1, 1), cB + hstep + kstep, voffB);
        PG8_WAIT_V(6); PG8_BAR;
    } else {
        PG8_STAGE(PG8_SB(0, 0), cB, voffB); PG8_STAGE(PG8_SA(0, 0), cA, voffA); PG8_STAGE(PG8_SB(0, 1), cB + hstep, voffB); PG8_STAGE(PG8_SA(0, 1), cA + hstep, voffA);
        if (wr == 1) PG8_BAR;
        PG8_WAIT_V(4); PG8_BAR;
        PG8_STAGE(PG8_SB(1, 0), cB + kstep, voffB); PG8_STAGE(PG8_SA(1, 0), cA + kstep, voffA); PG8_STAGE(PG8_SB(1, 1), cB + hstep + kstep, voffB);
        PG8_WAIT_V(6); PG8_BAR;
    }
    for (;;) {
        const bool has_next = S.next(ui + 1, nxt);
        const char* nA = has_next ? (const char*)g.A + (size_t)nxt.pm * tstep : cA; const char* nB = has_next ? (const char*)g.Bt + (size_t)nxt.pn * tstep : cB;
        for (int t = 0; t < nt; t += 2) {
            const bool last = (t == nt - 2);
            const char* a1 = cA + (size_t)(t + 1) * kstep;
            const char* a2 = last ? nA : cA + (size_t)(t + 2) * kstep; const char* b2 = last ? nB : cB + (size_t)(t + 2) * kstep;
            const char* a3 = a2 + kstep; const char* b3 = b2 + kstep;
            if (last && has_next) S.a_ready(nxt);
            if constexpr (SP2) {
            PG8_LDB(B0, 0, 0); PG8_LDB(B1, 0, 1); PG8_SCHED; PG8_LDA(At, 0, 0); PG8_STAGE(PG8_SA(1, 1), a1 + hstep, voffA);
            PG8_WAIT_V(8); PG8_WAIT_L(0); PG8_BAR; PG8_MMA(0, 0, At, B0); PG8_MMA(0, 1, At, B1); PG8_BAR; PG8_SCHED;
            PG8_LDA(At, 0, 1); PG8_STAGE(PG8_SB(0, 0), b2, voffB); PG8_STAGE(PG8_SB(0, 1), b2 + hstep, voffB); PG8_STAGE(PG8_SA(0, 0), a2, voffA);
            PG8_WAIT_V(8); PG8_WAIT_L(0); PG8_BAR; PG8_MMA(1, 0, At, B0); PG8_MMA(1, 1, At, B1); PG8_BAR; PG8_SCHED;
            PG8_LDB(B0, 1, 0); PG8_LDB(B1, 1, 1); PG8_SCHED; PG8_LDA(At, 1, 0); PG8_STAGE(PG8_SA(0, 1), a2 + hstep, voffA);
            PG8_WAIT_V(8); PG8_WAIT_L(0); PG8_BAR; PG8_MMA(0, 0, At, B0); PG8_MMA(0, 1, At, B1); PG8_BAR; PG8_SCHED;
            PG8_LDA(At, 1, 1); PG8_STAGE(PG8_SB(1, 0), b3, voffB); PG8_STAGE(PG8_SB(1, 1), b3 + hstep, voffB); PG8_STAGE(PG8_SA(1, 0), a3, voffA);
            PG8_WAIT_V(8); PG8_WAIT_L(0); PG8_BAR; PG8_MMA(1, 0, At, B0); PG8_MMA(1, 1, At, B1); PG8_BAR; PG8_SCHED;
            } else {
            PG8_LDB(B0, 0, 0); PG8_SCHED; PG8_LDA(At, 0, 0); PG8_STAGE(PG8_SA(1, 1), a1 + hstep, voffA);
            PG8_WAIT_L(8); PG8_BAR; PG8_WAIT_L(0); PG8_MMA(0, 0, At, B0); PG8_BAR; PG8_SCHED;
            PG8_LDB(B1, 0, 1); PG8_STAGE(PG8_SB(0, 0), b2, voffB);
            PG8_BAR; PG8_WAIT_L(0); PG8_MMA(0, 1, At, B1); PG8_BAR;
            PG8_LDA(At, 0, 1); PG8_STAGE(PG8_SA(0, 0), a2, voffA);
            PG8_BAR; PG8_WAIT_L(0); PG8_MMA(1, 0, At, B0); PG8_BAR; PG8_SCHED;
            PG8_STAGE(PG8_SB(0, 1), b2 + hstep, voffB);
            PG8_WAIT_V(6); PG8_BAR; PG8_MMA(1, 1, At, B1); PG8_BAR;
            PG8_LDB(B0, 1, 0); PG8_SCHED; PG8_LDA(At, 1, 0); PG8_STAGE(PG8_SA(0, 1), a2 + hstep, voffA);
            PG8_WAIT_L(8); PG8_BAR; PG8_WAIT_L(0); PG8_MMA(0, 0, At, B0); PG8_BAR; PG8_SCHED;
            PG8_LDB(B1, 1, 1); PG8_STAGE(PG8_SB(1, 0), b3, voffB);
            PG8_BAR; PG8_WAIT_L(0); PG8_MMA(0, 1, At, B1); PG8_BAR;
            PG8_LDA(At, 1, 1); PG8_STAGE(PG8_SA(1, 0), a3, voffA);
            PG8_BAR; PG8_WAIT_L(0); PG8_MMA(1, 0, At, B0); PG8_BAR; PG8_SCHED;
            PG8_STAGE(PG8_SB(1, 1), b3 + hstep, voffB);
            PG8_WAIT_V(6); PG8_BAR; PG8_MMA(1, 1, At, B1); PG8_BAR;
            }
        }
        if constexpr (ALIGN_EPI) { if (wr == 0) PG8_BAR; }
        if constexpr (!Epi::AFTER_DRAIN) { E(acc, cur, wr, wc, fr, fq); S.done(cur); }
        if (!has_next) break;
#pragma unroll
        for (int a = 0; a < 2; ++a)
#pragma unroll
            for (int b = 0; b < 2; ++b)
#pragma unroll
                for (int m = 0; m < 4; ++m)
#pragma unroll
                    for (int n = 0; n < 2; ++n) acc[a][b][m][n] = (f32x4){0.f, 0.f, 0.f, 0.f};
        cur = nxt; cA = nA; cB = nB; ++ui;
        if constexpr (ALIGN_EPI) { if (wr == 1) PG8_BAR; }
    }
    PG8_WAIT_V(0);
    if constexpr (!ALIGN_EPI) { if (wr == 0) PG8_BAR; }
    PG8_BAR;
    if constexpr (Epi::AFTER_DRAIN) { E.fused(acc, cur, wr, wc, fr, fq, lds, wid, lane); S.done(cur); }
#undef PG8_SA
#undef PG8_SB
#undef PG8_STAGE
#undef PG8_LDA
#undef PG8_LDB
#undef PG8_MMA
#undef PG8_WAIT_V
#undef PG8_WAIT_L
#undef PG8_BAR
#undef PG8_SCHED
}
}
namespace pg8 {
__device__ __forceinline__ float silu_f(float x) { return x * __builtin_amdgcn_rcpf(1.0f + __builtin_amdgcn_exp2f(-1.4426950408889634f * x)); }
struct EpiSplit4 {
    static constexpr bool PERM = true, AFTER_DRAIN = false;
    bf16_t* O; size_t split_stride; const float* sumsq; float qscale; int q_split, gate_split;
    __device__ __forceinline__ void operator()(const f32x4 (&acc)[2][2][4][2], const Unit& u, int wr, int wc, int fr, int fq) const {
        const int row0 = u.pm * BM + wr * 64 + fr; int colt = u.pn * BM; const int t = colt >> 10; colt &= 1023;
        bf16_t* base = O + (size_t)t * split_stride; const int col0 = colt + wc * 32 + 8 * fq;
        const float ts = (t == q_split) ? qscale : 1.f; const bool gate = (t == gate_split);
#pragma unroll
        for (int ai = 0; ai < 2; ++ai)
#pragma unroll
            for (int m = 0; m < 4; ++m) { const int row = row0 + ai * HALF + m * 16; float rs = ts;
                if (sumsq) rs *= 1.0f / sqrtf(sumsq[row] * (1.0f / 1024.0f) + 1e-6f);
                bf16_t* rowp = base + (size_t)row * 1024 + col0;
#pragma unroll
                for (int bj = 0; bj < 2; ++bj) { f32x4 v0 = acc[ai][bj][m][0] * rs, v1 = acc[ai][bj][m][1] * rs;
                    if (gate) { v0 = (f32x4){silu_f(v0[0]), silu_f(v0[1]), silu_f(v0[2]), silu_f(v0[3])}; v1 = (f32x4){silu_f(v1[0]), silu_f(v1[1]), silu_f(v1[2]), silu_f(v1[3])}; }
                    u32x4 w; w.x = cvt_pk_bf16(v0[0], v0[1]); w.y = cvt_pk_bf16(v0[2], v0[3]); w.z = cvt_pk_bf16(v1[0], v1[1]); w.w = cvt_pk_bf16(v1[2], v1[3]);
                    *(u32x4*)(rowp + bj * HALF) = w; } }
    }
};
struct EpiRes {
    static constexpr bool PERM = true, AFTER_DRAIN = false;
    const float* base; float* out; bf16_t* xa; float* sumsq;
    __device__ __forceinline__ void load_batch(f32x4 (&b)[2][2][2], int q, int row0, int col0) const {
#pragma unroll
        for (int mm = 0; mm < 2; ++mm)
#pragma unroll
            for (int bj = 0; bj < 2; ++bj) { const size_t off = (size_t)(row0 + (q >> 1) * HALF + (2 * (q & 1) + mm) * 16) * 1024 + col0 + bj * HALF; b[mm][bj][0] = *(const f32x4*)(base + off); b[mm][bj][1] = *(const f32x4*)(base + off + 4); }
    }
    __device__ __forceinline__ void store_batch(const f32x4 (&b)[2][2][2], const f32x4 (&acc)[2][2][4][2], int q, int row0, int col0, int fq, int pslot) const {
#pragma unroll
        for (int mm = 0; mm < 2; ++mm) { const int ai = q >> 1, m = 2 * (q & 1) + mm; const int row = row0 + ai * HALF + m * 16; const size_t off = (size_t)row * 1024 + col0; float ss = 0.f;
#pragma unroll
            for (int bj = 0; bj < 2; ++bj) { const f32x4 v0 = b[mm][bj][0] + acc[ai][bj][m][0], v1 = b[mm][bj][1] + acc[ai][bj][m][1];
                if (out) { *(f32x4*)(out + off + bj * HALF) = v0; *(f32x4*)(out + off + bj * HALF + 4) = v1; }
                ss += (v0[0] * v0[0] + v0[1] * v0[1]) + (v0[2] * v0[2] + v0[3] * v0[3]) + (v1[0] * v1[0] + v1[1] * v1[1]) + (v1[2] * v1[2] + v1[3] * v1[3]);
                if (xa) { u32x4 w; w.x = cvt_pk_bf16(v0[0], v0[1]); w.y = cvt_pk_bf16(v0[2], v0[3]); w.z = cvt_pk_bf16(v1[0], v1[1]); w.w = cvt_pk_bf16(v1[2], v1[3]);
                    *(u32x4*)(xa + off + bj * HALF) = w; } }
            if (sumsq) { ss += __shfl_xor(ss, 16); ss += __shfl_xor(ss, 32); if (fq == 0) atomicAdd(sumsq + row, ss); } }
    }
    __device__ __forceinline__ void operator()(const f32x4 (&acc)[2][2][4][2], const Unit& u, int wr, int wc, int fr, int fq) const {
        const int row0 = u.pm * BM + wr * 64 + fr; const int col0 = u.pn * BM + wc * 32 + 8 * fq; const int pslot = u.pn * 4 + wc;
        f32x4 b0[2][2][2], b1[2][2][2];
        load_batch(b0, 0, row0, col0);
        load_batch(b1, 1, row0, col0); store_batch(b0, acc, 0, row0, col0, fq, pslot);
        load_batch(b0, 2, row0, col0); store_batch(b1, acc, 1, row0, col0, fq, pslot);
        load_batch(b1, 3, row0, col0); store_batch(b0, acc, 2, row0, col0, fq, pslot);
        store_batch(b1, acc, 3, row0, col0, fq, pslot);
    }
};

struct EpiResBf {
    static constexpr bool PERM = true, AFTER_DRAIN = false;
    const bf16_t* resid; float* out;
    __device__ __forceinline__ void operator()(const f32x4 (&acc)[2][2][4][2], const Unit& u, int wr, int wc, int fr, int fq) const {
        const int row0 = u.pm * BM + wr * 64 + fr; const int col0 = u.pn * BM + wc * 32 + 8 * fq;
        u32x4 r[2][4][2];
#pragma unroll
        for (int ai = 0; ai < 2; ++ai)
#pragma unroll
            for (int m = 0; m < 4; ++m)
#pragma unroll
                for (int bj = 0; bj < 2; ++bj) r[ai][m][bj] = *(const u32x4*)(resid + (size_t)(row0 + ai * HALF + m * 16) * 1024 + col0 + bj * HALF);
#pragma unroll
        for (int ai = 0; ai < 2; ++ai)
#pragma unroll
            for (int m = 0; m < 4; ++m) { const size_t off = (size_t)(row0 + ai * HALF + m * 16) * 1024 + col0;
#pragma unroll
                for (int bj = 0; bj < 2; ++bj) { const u32x4 w = r[ai][m][bj];
                    const f32x4 b0 = {__uint_as_float(w.x << 16), __uint_as_float(w.x & 0xffff0000u), __uint_as_float(w.y << 16), __uint_as_float(w.y & 0xffff0000u)};
                    const f32x4 b1 = {__uint_as_float(w.z << 16), __uint_as_float(w.z & 0xffff0000u), __uint_as_float(w.w << 16), __uint_as_float(w.w & 0xffff0000u)};
                    *(f32x4*)(out + off + bj * HALF) = acc[ai][bj][m][0] + b0; *(f32x4*)(out + off + bj * HALF + 4) = acc[ai][bj][m][1] + b1; } }
    }
};

struct EpiB {
    static constexpr bool PERM = true, AFTER_DRAIN = false;
    bf16_t* O; size_t split_stride; const float* sumsq; const float* kg; const float* qg; const unsigned* rope; float qs; const float* subg; float post;
    __device__ __forceinline__ void operator()(const f32x4 (&acc)[2][2][4][2], const Unit& u, int wr, int wc, int fr, int fq) const {
        const int row0 = u.pm * BM + wr * 64 + fr; int colt = u.pn * BM; const int t = colt >> 10; colt &= 1023;
        bf16_t* base = O + (size_t)t * split_stride;
        float rsv[2][4];
#pragma unroll
        for (int ai = 0; ai < 2; ++ai)
#pragma unroll
            for (int m = 0; m < 4; ++m) rsv[ai][m] = __builtin_amdgcn_rsqf(sumsq[row0 + ai * HALF + m * 16] * (1.0f / 1024.0f) + 1e-6f);
        if (t & 1) {
            const int col0 = colt + wc * 32 + 8 * fq; const bool gate = (t == 3);
            f32x4 sg0 = {1.f, 1.f, 1.f, 1.f}, sg1 = sg0;
            if (gate) { sg0 = *(const f32x4*)(subg + wc * 32 + 8 * fq) * post; sg1 = *(const f32x4*)(subg + wc * 32 + 8 * fq + 4) * post; }
#pragma unroll
            for (int ai = 0; ai < 2; ++ai)
#pragma unroll
                for (int m = 0; m < 4; ++m) { const int row = row0 + ai * HALF + m * 16; const float rs = rsv[ai][m];
                    bf16_t* rowp = base + (size_t)row * 1024 + col0;
#pragma unroll
                    for (int bj = 0; bj < 2; ++bj) { f32x4 v0 = acc[ai][bj][m][0] * rs, v1 = acc[ai][bj][m][1] * rs;
                        if (gate) { v0 = (f32x4){silu_f(v0[0]), silu_f(v0[1]), silu_f(v0[2]), silu_f(v0[3])} * sg0; v1 = (f32x4){silu_f(v1[0]), silu_f(v1[1]), silu_f(v1[2]), silu_f(v1[3])} * sg1; }
                        u32x4 w; w.x = cvt_pk_bf16(v0[0], v0[1]); w.y = cvt_pk_bf16(v0[2], v0[3]); w.z = cvt_pk_bf16(v1[0], v1[1]); w.w = cvt_pk_bf16(v1[2], v1[3]);
                        *(u32x4*)(rowp + bj * HALF) = w; } }
        } else {
            const float* g = (t == 0) ? kg : qg; const float sc = (t == 2) ? qs : 1.0f;
            f32x4 g1[2], g2[2];
#pragma unroll
            for (int n = 0; n < 2; ++n) { g1[n] = *(const f32x4*)(g + 8 * fq + 4 * n) * sc; g2[n] = *(const f32x4*)(g + 32 + 8 * fq + 4 * n) * sc; }
            const int colc = colt + wc * 64 + 8 * fq;
#pragma unroll
            for (int ai = 0; ai < 2; ++ai)
#pragma unroll
                for (int m = 0; m < 4; ++m) { const int row = row0 + ai * HALF + m * 16; const float rs = rsv[ai][m];
                    f32x4 a1[2], a2[2]; float ss = 0.f;
#pragma unroll
                    for (int n = 0; n < 2; ++n) { a1[n] = acc[ai][0][m][n] * rs; a2[n] = acc[ai][1][m][n] * rs;
                        ss += (a1[n][0] * a1[n][0] + a1[n][1] * a1[n][1]) + (a1[n][2] * a1[n][2] + a1[n][3] * a1[n][3]) + (a2[n][0] * a2[n][0] + a2[n][1] * a2[n][1]) + (a2[n][2] * a2[n][2] + a2[n][3] * a2[n][3]); }
                    ss += __shfl_xor(ss, 16); ss += __shfl_xor(ss, 32);
                    const float cr = __builtin_amdgcn_rsqf(ss * (1.0f / 64.0f) + 1e-6f);
                    const u32x4* rp = (const u32x4*)(rope + (size_t)row * 32 + 8 * fq);
                    f32x4 o1[2], o2[2];
#pragma unroll
                    for (int n = 0; n < 2; ++n) { const f32x4 t1 = a1[n] * cr * g1[n], t2 = a2[n] * cr * g2[n]; const u32x4 cw = rp[n];
                        const f32x4 cc = {__uint_as_float(cw.x << 16), __uint_as_float(cw.y << 16), __uint_as_float(cw.z << 16), __uint_as_float(cw.w << 16)};
                        const f32x4 sn = {__uint_as_float(cw.x & 0xffff0000u), __uint_as_float(cw.y & 0xffff0000u), __uint_as_float(cw.z & 0xffff0000u), __uint_as_float(cw.w & 0xffff0000u)};
                        o1[n] = t1 * cc - t2 * sn; o2[n] = t2 * cc + t1 * sn; }
                    bf16_t* rowp = base + (size_t)row * 1024 + colc; u32x4 w;
                    w.x = cvt_pk_bf16(o1[0][0], o1[0][1]); w.y = cvt_pk_bf16(o1[0][2], o1[0][3]); w.z = cvt_pk_bf16(o1[1][0], o1[1][1]); w.w = cvt_pk_bf16(o1[1][2], o1[1][3]); *(u32x4*)(rowp) = w;
                    w.x = cvt_pk_bf16(o2[0][0], o2[0][1]); w.y = cvt_pk_bf16(o2[0][2], o2[0][3]); w.z = cvt_pk_bf16(o2[1][0], o2[1][1]); w.w = cvt_pk_bf16(o2[1][2], o2[1][3]); *(u32x4*)(rowp + 32) = w; }
        }
    }
};
}
namespace mk {
#define LAS __attribute__((address_space(3)))
typedef unsigned short bf16;
typedef unsigned u32x4 __attribute__((ext_vector_type(4)));
typedef float f32x4 __attribute__((ext_vector_type(4)));
typedef float f32x16 __attribute__((ext_vector_type(16)));
typedef short bf16x8 __attribute__((ext_vector_type(8)));
typedef short s16x4 __attribute__((ext_vector_type(4)));
typedef short v4i16_t __attribute__((ext_vector_type(4)));
typedef float f32x2 __attribute__((ext_vector_type(2)));

constexpr int BATCH = 2, SEQ = 8192, DM = 1024, M = BATCH * SEQ, NWAVES = 8, NTHR = 512;
constexpr float EPS = 1e-6f, LOG2E = 1.4426950408889634f, QS = 0.125f * LOG2E;
constexpr float SB_MASS = 2.3283064365386963e-10f;
constexpr size_t MiB = 1u << 20;
constexpr size_t WS_SUMSQ = 0;
constexpr size_t WS_BAR = 256 * 1024;
constexpr size_t WS_ROPE = 1 * MiB;
constexpr size_t WS_WINA = 5 * MiB;
constexpr size_t WS_WOUTA = 13 * MiB;
constexpr size_t WS_WB = 15 * MiB;
constexpr size_t WS_WOUTB = 23 * MiB;
constexpr size_t WS_XA = 32 * MiB;
constexpr size_t WS_T = 64 * MiB;
constexpr size_t WS_O = 192 * MiB;
constexpr size_t WS_END = 224 * MiB;
constexpr size_t TSTRIDE = (size_t)M * DM;
constexpr int RING_BYTES = 131072, LDS_BYTES = 143360;
constexpr int DIFF_WSF = 137216, LDS_CTL = 141312;
constexpr int ATT_WSF = 98304, ATT_FLAGS = 98304 + 2048;

__device__ __forceinline__ int crow(int r, int hi) { return (r & 3) + 8 * (r >> 2) + 4 * hi; }
__device__ __forceinline__ unsigned cvtpk(float lo, float hi) { typedef __bf16 b2 __attribute__((ext_vector_type(2))); f32x2 v = {lo, hi}; b2 b = __builtin_convertvector(v, b2); return __builtin_bit_cast(unsigned, b); }
__device__ __forceinline__ float bf2f(unsigned short b) { return __uint_as_float((unsigned)b << 16); }
__device__ __forceinline__ s16x4 vtr(const LAS unsigned char* p) { return __builtin_bit_cast(s16x4, __builtin_amdgcn_ds_read_tr16_b64_v4i16((LAS v4i16_t*)p)); }
__device__ __forceinline__ float wave_sum(float v) {
#pragma unroll
    for (int o = 1; o < 64; o <<= 1) v += __shfl_xor(v, o);
    return v;
}
__device__ __forceinline__ float wave_max(float v) {
#pragma unroll
    for (int o = 1; o < 64; o <<= 1) v = fmaxf(v, __shfl_xor(v, o));
    return v;
}
#define MFMA32(a, b, c) __builtin_amdgcn_mfma_f32_32x32x16_bf16(a, b, c, 0, 0, 0)

struct KVMap { int kg0, kg1, vg0, vg1, kl0, kl1, vl0, vl1; };
struct KVStage { u32x4 k0, k1, v0, v1; };
__device__ __forceinline__ KVMap kv_map(int w, int lane) {
    KVMap m; const int krow = 16 * (w >> 1) + (lane >> 2); const int kc0 = 8 * (w & 1) + (lane & 3), kc1 = kc0 + 4;
    m.kg0 = krow * DM + 8 * kc0; m.kg1 = krow * DM + 8 * kc1;
    m.kl0 = (kc0 >> 3) * 8448 + (kc0 & 7) * 1056 + krow * 16; m.kl1 = (kc1 >> 3) * 8448 + (kc1 & 7) * 1056 + krow * 16;
    const int vr0 = 8 * w + (lane >> 4), vr1 = vr0 + 4, vch = lane & 15;
    m.vg0 = vr0 * DM + 8 * vch; m.vg1 = vr1 * DM + 8 * vch;
    m.vl0 = 17408 + (vch >> 2) * 4160 + vr0 * 64 + (vch & 3) * 16; m.vl1 = 17408 + (vch >> 2) * 4160 + vr1 * 64 + (vch & 3) * 16;
    return m;
}
__device__ __forceinline__ void kv_gload(KVStage& s, const bf16* Kt, const bf16* Vt, const KVMap& m) {
    s.k0 = *(const u32x4*)(Kt + m.kg0); s.k1 = *(const u32x4*)(Kt + m.kg1); s.v0 = *(const u32x4*)(Vt + m.vg0); s.v1 = *(const u32x4*)(Vt + m.vg1);
}
__device__ __forceinline__ void kv_lstore(const KVStage& s, LAS unsigned char* buf, const KVMap& m) {
    *(LAS u32x4*)(buf + m.kl0) = s.k0; *(LAS u32x4*)(buf + m.kl1) = s.k1; *(LAS u32x4*)(buf + m.vl0) = s.v0; *(LAS u32x4*)(buf + m.vl1) = s.v1;
}
__device__ __forceinline__ void qk_tile(f32x16& p0, f32x16& p1, const LAS unsigned char* kb, const bf16x8 (&qr)[4], float init) {
#pragma unroll
    for (int r = 0; r < 16; ++r) { p0[r] = init; p1[r] = init; }
    constexpr int RD = 3;
    bf16x8 kf[8];
#define KADDR(i) (kb + ((i) >> 1) * 2112 + ((i) & 1) * 512)
#pragma unroll
    for (int i = 0; i < RD; ++i) kf[i] = *(const LAS bf16x8*)KADDR(i);
    __builtin_amdgcn_sched_barrier(0);
#pragma unroll
    for (int i = 0; i < 8; ++i) {
        if (i + RD < 8) kf[i + RD] = *(const LAS bf16x8*)KADDR(i + RD);
        if (i & 1) p1 = MFMA32(kf[i], qr[i >> 1], p1); else p0 = MFMA32(kf[i], qr[i >> 1], p0);
        __builtin_amdgcn_sched_barrier(0);
    }
#undef KADDR
}
template <int NDB> __device__ __forceinline__ void pv_tile(f32x16 (&o)[NDB], const LAS unsigned char* vb, const f32x16& p0, const f32x16& p1) {
    bf16x8 pa[4];
    { u32x4 w;
      w = (u32x4){cvtpk(p0[0], p0[1]), cvtpk(p0[2], p0[3]), cvtpk(p0[4], p0[5]), cvtpk(p0[6], p0[7])}; pa[0] = __builtin_bit_cast(bf16x8, w);
      w = (u32x4){cvtpk(p0[8], p0[9]), cvtpk(p0[10], p0[11]), cvtpk(p0[12], p0[13]), cvtpk(p0[14], p0[15])}; pa[1] = __builtin_bit_cast(bf16x8, w);
      w = (u32x4){cvtpk(p1[0], p1[1]), cvtpk(p1[2], p1[3]), cvtpk(p1[4], p1[5]), cvtpk(p1[6], p1[7])}; pa[2] = __builtin_bit_cast(bf16x8, w);
      w = (u32x4){cvtpk(p1[8], p1[9]), cvtpk(p1[10], p1[11]), cvtpk(p1[12], p1[13]), cvtpk(p1[14], p1[15])}; pa[3] = __builtin_bit_cast(bf16x8, w); }
    constexpr int N = 4 * NDB, RD = 3;
    s16x4 lo[N], hi[N];
#define VADDR(i) (vb + ((i) % NDB) * 4160 + ((i) / NDB) * 1024)
#pragma unroll
    for (int i = 0; i < RD; ++i) { lo[i] = vtr(VADDR(i)); hi[i] = vtr(VADDR(i) + 512); }
    __builtin_amdgcn_sched_barrier(0);
#pragma unroll
    for (int i = 0; i < N; ++i) {
        if (i + RD < N) { lo[i + RD] = vtr(VADDR(i + RD)); hi[i + RD] = vtr(VADDR(i + RD) + 512); }
        const bf16x8 vf = {lo[i][0], lo[i][1], lo[i][2], lo[i][3], hi[i][0], hi[i][1], hi[i][2], hi[i][3]};
        o[i % NDB] = MFMA32(pa[i / NDB], vf, o[i % NDB]);
        __builtin_amdgcn_sched_barrier(0);
    }
#undef VADDR
}
template <int MODE> __device__ __forceinline__ void row_pass(const LAS float* E, int tid, size_t grow0, int col0, const bf16* G, bf16* O, const float* subg, float post) {
    const int row = tid >> 2, seg = tid & 3; const LAS float* e = E + row * 132 + 32 * seg;
    float v[32];
#pragma unroll
    for (int i = 0; i < 8; ++i) { const f32x4 x = *(const LAS f32x4*)(e + 4 * i); v[4 * i] = x[0]; v[4 * i + 1] = x[1]; v[4 * i + 2] = x[2]; v[4 * i + 3] = x[3]; }
    if (MODE == 1) { float ss = 0.f;
#pragma unroll
        for (int i = 0; i < 32; ++i) ss += v[i] * v[i];
        ss += __shfl_xor(ss, 1); ss += __shfl_xor(ss, 2);
        const float rstd = 1.0f / sqrtf(ss * (1.0f / 128.0f) + EPS);
#pragma unroll
        for (int i = 0; i < 32; ++i) v[i] *= rstd; }
    const size_t off = (grow0 + row) * DM + col0 + 32 * seg;
#pragma unroll
    for (int i = 0; i < 4; ++i) { const u32x4 g = *(const u32x4*)(G + off + 8 * i); u32x4 w;
#pragma unroll
        for (int j = 0; j < 4; ++j) { const float lo = v[8 * i + 2 * j] * __uint_as_float(g[j] << 16), hi = v[8 * i + 2 * j + 1] * __uint_as_float(g[j] & 0xffff0000u); w[j] = cvtpk(lo, hi); }
        *(u32x4*)(O + off + 8 * i) = w; }
}

#define XB_TMO      128
#define XB_XCNT(j)  (256  + 64 * (j))
#define XB_XSUB(j)  (1280 + 64 * (j))
#define XB_XGEN(j)  (2304 + 64 * (j))
#define XB_TOP      3328
#define XB_TOPGEN   3392
#define XCD_BAR_WORDS 3456
#define XB_SPIN_CAP (1u << 18)

__device__ __forceinline__ unsigned xb_ld(unsigned* p)              { return __hip_atomic_load(p, __ATOMIC_RELAXED, __HIP_MEMORY_SCOPE_AGENT); }
__device__ __forceinline__ unsigned xb_add(unsigned* p, unsigned v) { return __hip_atomic_fetch_add(p, v, __ATOMIC_RELAXED, __HIP_MEMORY_SCOPE_AGENT); }
__device__ __forceinline__ unsigned xb_xcc_id() { return (unsigned)__builtin_amdgcn_s_getreg((3 << 11) | 20) & 0xFu; }
#define XB_SPIN(cond, bar) do { unsigned _sp = 0; while (cond) { __builtin_amdgcn_s_sleep(1); \
    if ((++_sp & 255u) == 0u) { if (xb_ld(&(bar)[XB_TMO])) break; if (_sp > XB_SPIN_CAP) { atomicAdd(&(bar)[XB_TMO], 1u); break; } } } } while (0)

struct XcdBarrier {
    unsigned* bar; unsigned x;
    volatile LAS unsigned* st;
};

__device__ __forceinline__ XcdBarrier xcd_barrier_post(unsigned* bar, volatile LAS unsigned* st) {
    XcdBarrier b; b.bar = bar; b.x = xb_xcc_id(); b.st = st;
    if (threadIdx.x == 0) (void)xb_add(&bar[XB_XCNT(b.x)], 1u);
    return b;
}
__device__ __forceinline__ void xcd_barrier_complete(unsigned* bar, unsigned x, unsigned& nloc, unsigned& nx) {
    const unsigned G = gridDim.x * gridDim.y * gridDim.z;
    unsigned sum, cnt, mine, sp = 0u;
    for (;;) {
        sum = 0u; cnt = 0u; mine = 0u;
#pragma unroll
        for (unsigned j = 0; j < 16; ++j) { const unsigned c = xb_ld(&bar[XB_XCNT(j)]); sum += c; cnt += (c > 0u) ? 1u : 0u; mine = (j == x) ? c : mine; }
        if (sum == G) break;
        __builtin_amdgcn_s_sleep(1);
        if ((++sp & 255u) == 0u) { if (xb_ld(&bar[XB_TMO])) break; if (sp > XB_SPIN_CAP) { atomicAdd(&bar[XB_TMO], 1u); break; } }
    }
    nloc = mine > 0u ? mine : 1u; nx = cnt > 0u ? cnt : 1u;
}

__device__ __forceinline__ void xcd_barrier(const XcdBarrier& b) {
    asm volatile("s_waitcnt vmcnt(0)" ::: "memory");
    __syncthreads();
    if (threadIdx.x == 0) {
        unsigned* bar = b.bar;
        __builtin_amdgcn_s_waitcnt(0);
        unsigned nloc = b.st[0], nx = b.st[1];
        if (nloc == 0u) { xcd_barrier_complete(bar, b.x, nloc, nx); b.st[0] = nloc; b.st[1] = nx; }
        const unsigned old = xb_add(&bar[XB_XSUB(b.x)], 1u);
        const unsigned gen = old / nloc;
        if (old + 1u == (gen + 1u) * nloc) {
            __builtin_amdgcn_fence(__ATOMIC_RELEASE, "agent");
            asm volatile("s_waitcnt vmcnt(0)" ::: "memory");
            const unsigned og = xb_add(&bar[XB_TOP], 1u);
            const unsigned tg = og / nx;
            if (og + 1u == (tg + 1u) * nx) xb_add(&bar[XB_TOPGEN], 1u);
            else XB_SPIN(xb_ld(&bar[XB_TOPGEN]) == tg, bar);
            __builtin_amdgcn_fence(__ATOMIC_ACQUIRE, "agent");
            xb_add(&bar[XB_XGEN(b.x)], 1u);
            asm volatile("s_waitcnt vmcnt(0)" ::: "memory");
        } else {
            XB_SPIN(xb_ld(&bar[XB_XGEN(b.x)]) == gen, bar);
            __builtin_amdgcn_fence(__ATOMIC_ACQUIRE, "agent");
            asm volatile("s_waitcnt vmcnt(0)" ::: "memory");
        }
    }
    __syncthreads();
}

__device__ __forceinline__ void stick_attn_phase(LAS unsigned char* lds, int vcu, int G, const bf16* Qt, const bf16* Kt, const bf16* Vt, const bf16* Gt, bf16* Ot) {
    int tid_ = threadIdx.x; asm volatile("" : "+v"(tid_)); const int tid = tid_, lane = tid & 63, w = __builtin_amdgcn_readfirstlane(tid >> 6), r32 = lane & 31, hi = lane >> 5;
    const int c = w >> 2, jw = w & 3;
    const KVMap map = kv_map(w, lane);
    const LAS unsigned char* kfb = lds + c * 8448 + hi * 1056 + r32 * 16;
    const LAS unsigned char* vfb = lds + 17408 + (2 * c) * 4160 + (4 * hi + ((lane & 15) >> 2)) * 64 + ((lane >> 4) & 1) * 32 + (lane & 3) * 8;
    LAS float* E = (LAS float*)lds;
    volatile LAS float* flags = (volatile LAS float*)(lds + ATT_FLAGS);
    for (int u = vcu; u < 1024; u += G) {
        const int bhp = u >> 6, qb = u & 63, b = bhp >> 3, hp = bhp & 7;
        const size_t rowbase = (size_t)b * SEQ; const int q0 = qb * 128, q0w = q0 + 32 * jw, qrow = q0w + r32, col0 = hp * 128;
        const int tmax = 2 * qb + 1, tw = (q0w + 30) >> 6;
        bf16x8 qr[4];
#pragma unroll
        for (int d0 = 0; d0 < 4; ++d0) qr[d0] = *(const bf16x8*)(Qt + (rowbase + qrow) * DM + col0 + c * 64 + d0 * 16 + hi * 8);
        f32x16 o[2];
#pragma unroll
        for (int r = 0; r < 16; ++r) { o[0][r] = 0.f; o[1][r] = 0.f; }
        float crun = 1.0f; bool active = true;
        KVStage st;
        kv_gload(st, Kt + (rowbase + 64 * tmax) * DM + col0, Vt + (rowbase + 64 * tmax) * DM + col0, map);
        kv_lstore(st, lds, map);
        __builtin_amdgcn_s_waitcnt(0);
        __syncthreads();
        int it = 0;
        for (int t = tmax; t >= 0; --t, ++it) {
            const int cur = it & 1;
            if (t > 0) kv_gload(st, Kt + (rowbase + 64 * (t - 1)) * DM + col0, Vt + (rowbase + 64 * (t - 1)) * DM + col0, map);
            if (active && t <= tw) {
                f32x16 p0, p1, l0, l1;
                qk_tile(p0, p1, kfb + cur * 34048, qr, 0.f);
                const bool need_mask = (64 * t + 63 >= q0w);
                const int kv0 = 64 * t;
#pragma unroll
                for (int r = 0; r < 16; ++r) {
                    { const float z = p0[r], e = __builtin_amdgcn_exp2f(-fabsf(z)), rr = __builtin_amdgcn_rcpf(1.0f + e), er = e * rr; float nb = (z >= 0.f) ? er : rr, bb = (z >= 0.f) ? rr : er;
                      if (need_mask && (kv0 + crow(r, hi) >= qrow)) { nb = 1.f; bb = 0.f; } l0[r] = nb; p0[r] = bb; }
                    { const float z = p1[r], e = __builtin_amdgcn_exp2f(-fabsf(z)), rr = __builtin_amdgcn_rcpf(1.0f + e), er = e * rr; float nb = (z >= 0.f) ? er : rr, bb = (z >= 0.f) ? rr : er;
                      if (need_mask && (kv0 + 32 + crow(r, hi) >= qrow)) { nb = 1.f; bb = 0.f; } l1[r] = nb; p1[r] = bb; }
                }
                float S[16];
#pragma unroll
                for (int g = 0; g < 4; ++g) {
                    const float s0 = (l0[4 * g] * l0[4 * g + 1]) * (l0[4 * g + 2] * l0[4 * g + 3]);
                    const float s1 = (l1[4 * g] * l1[4 * g + 1]) * (l1[4 * g + 2] * l1[4 * g + 3]);
                    auto ra = __builtin_amdgcn_permlane32_swap(__float_as_uint(s0), __float_as_uint(s0), false, false);
                    auto rb = __builtin_amdgcn_permlane32_swap(__float_as_uint(s1), __float_as_uint(s1), false, false);
                    S[2 * g] = __uint_as_float(ra[0]); S[2 * g + 1] = __uint_as_float(ra[1]); S[8 + 2 * g] = __uint_as_float(rb[0]); S[8 + 2 * g + 1] = __uint_as_float(rb[1]);
                }
                float suf[16]; suf[15] = crun;
#pragma unroll
                for (int g = 14; g >= 0; --g) suf[g] = suf[g + 1] * S[g + 1];
                crun = suf[0] * S[0];
#pragma unroll
                for (int g = 0; g < 4; ++g) {
                    { const float e3 = hi ? suf[2 * g + 1] : suf[2 * g], e2 = e3 * l0[4 * g + 3], e1 = e2 * l0[4 * g + 2], e0 = e1 * l0[4 * g + 1];
                      p0[4 * g] *= e0; p0[4 * g + 1] *= e1; p0[4 * g + 2] *= e2; p0[4 * g + 3] *= e3; }
                    { const float e3 = hi ? suf[8 + 2 * g + 1] : suf[8 + 2 * g], e2 = e3 * l1[4 * g + 3], e1 = e2 * l1[4 * g + 2], e0 = e1 * l1[4 * g + 1];
                      p1[4 * g] *= e0; p1[4 * g + 1] *= e1; p1[4 * g + 2] *= e2; p1[4 * g + 3] *= e3; }
                }
                pv_tile<2>(o, vfb + cur * 34048, p0, p1);
                float mx = crun;
#pragma unroll
                for (int off = 1; off < 32; off <<= 1) mx = fmaxf(mx, __shfl_xor(mx, off));
                if (mx <= SB_MASS) active = false;
            }
            if (lane == 0) flags[cur * 8 + w] = active ? 0.f : 1.f;
            if (t > 0) kv_lstore(st, lds + (cur ^ 1) * 34048, map);
            __syncthreads();
            float fs = 0.f;
#pragma unroll
            for (int i = 0; i < 8; ++i) fs += flags[cur * 8 + i];
            if (fs >= 7.5f) break;
        }
#pragma unroll
        for (int db = 0; db < 2; ++db)
#pragma unroll
            for (int r = 0; r < 16; ++r) E[(32 * jw + crow(r, hi)) * 132 + 64 * c + 32 * db + r32] = o[db][r];
        __syncthreads();
        row_pass<0>(E, tid, rowbase + q0, col0, Gt, Ot, nullptr, 1.f);
        __syncthreads();
    }
}

#define DSB() __builtin_amdgcn_sched_barrier(0)
#define EXP4_ASM(P, R, S0, S1) asm volatile("v_exp_f32_e32 %0, %0\n\tv_exp_f32_e32 %1, %1\n\tv_exp_f32_e32 %2, %2\n\tv_exp_f32_e32 %3, %3\n\t" \
    "v_add_f32_e32 %4, %4, %0\n\tv_add_f32_e32 %5, %5, %1\n\tv_add_f32_e32 %4, %4, %2\n\tv_add_f32_e32 %5, %5, %3" \
    : "+v"(P[R]), "+v"(P[R + 1]), "+v"(P[R + 2]), "+v"(P[R + 3]), "+v"(S0), "+v"(S1))
#define EXP4_FIRST(P, S0, S1) do { P[0] = __builtin_amdgcn_exp2f(P[0]); P[1] = __builtin_amdgcn_exp2f(P[1]); P[2] = __builtin_amdgcn_exp2f(P[2]); P[3] = __builtin_amdgcn_exp2f(P[3]); \
    S0 = P[0] + P[2]; S1 = P[1] + P[3]; } while (0)
__device__ __forceinline__ void diff_tile(f32x16 (&o)[4], float& lsum, const LAS unsigned char* kb, const LAS unsigned char* vb, const bf16x8 (&qr)[4], float negm, bool need_mask, int lim) {
    f32x16 p0, p1;
#pragma unroll
    for (int r = 0; r < 16; ++r) { p0[r] = negm; p1[r] = negm; }
    bf16x8 kf[8];
#define KADDR(i) (kb + ((i) & 3) * 2112 + ((i) >> 2) * 512)
#define VADDR(i) (vb + ((i) & 3) * 4160 + ((i) >> 2) * 1024)
    kf[0] = *(const LAS bf16x8*)KADDR(0); kf[1] = *(const LAS bf16x8*)KADDR(1); kf[2] = *(const LAS bf16x8*)KADDR(2);
    DSB();
#pragma unroll
    for (int i = 0; i < 4; ++i) { kf[i + 3] = *(const LAS bf16x8*)KADDR(i + 3); p0 = MFMA32(kf[i], qr[i], p0); DSB(); }
    float s0, s1, s2, s3;
    s16x4 lo[16], hh[16];
    kf[7] = *(const LAS bf16x8*)KADDR(7); p1 = MFMA32(kf[4], qr[0], p1);
    if (need_mask) {
#pragma unroll
        for (int r = 0; r < 16; ++r) if ((r & 3) + 8 * (r >> 2) > lim) p0[r] = -INFINITY; }
    EXP4_FIRST(p0, s0, s1); DSB();
    p1 = MFMA32(kf[5], qr[1], p1); EXP4_ASM(p0, 4, s0, s1); DSB();
    p1 = MFMA32(kf[6], qr[2], p1); EXP4_ASM(p0, 8, s0, s1); lo[0] = vtr(VADDR(0)); hh[0] = vtr(VADDR(0) + 512); DSB();
    p1 = MFMA32(kf[7], qr[3], p1); EXP4_ASM(p0, 12, s0, s1); lo[1] = vtr(VADDR(1)); hh[1] = vtr(VADDR(1) + 512); DSB();
    bf16x8 pa[4];
    { u32x4 w;
      w = (u32x4){cvtpk(p0[0], p0[1]), cvtpk(p0[2], p0[3]), cvtpk(p0[4], p0[5]), cvtpk(p0[6], p0[7])}; pa[0] = __builtin_bit_cast(bf16x8, w);
      w = (u32x4){cvtpk(p0[8], p0[9]), cvtpk(p0[10], p0[11]), cvtpk(p0[12], p0[13]), cvtpk(p0[14], p0[15])}; pa[1] = __builtin_bit_cast(bf16x8, w); }
    lo[2] = vtr(VADDR(2)); hh[2] = vtr(VADDR(2) + 512);
    DSB();
#define PVSTEP(i) do { if ((i) + 3 < 16) { lo[(i) + 3] = vtr(VADDR((i) + 3)); hh[(i) + 3] = vtr(VADDR((i) + 3) + 512); } \
        { const bf16x8 vf_ = {lo[i][0], lo[i][1], lo[i][2], lo[i][3], hh[i][0], hh[i][1], hh[i][2], hh[i][3]}; o[(i) & 3] = MFMA32(pa[(i) >> 2], vf_, o[(i) & 3]); } } while (0)
    PVSTEP(0);
    if (need_mask) {
#pragma unroll
        for (int r = 0; r < 16; ++r) if (32 + (r & 3) + 8 * (r >> 2) > lim) p1[r] = -INFINITY; }
    EXP4_FIRST(p1, s2, s3); DSB();
    PVSTEP(1); DSB();
    PVSTEP(2); EXP4_ASM(p1, 4, s2, s3); DSB();
    PVSTEP(3); DSB();
    PVSTEP(4); EXP4_ASM(p1, 8, s2, s3); DSB();
    PVSTEP(5); DSB();
    PVSTEP(6); EXP4_ASM(p1, 12, s2, s3); DSB();
    PVSTEP(7);
    { u32x4 w;
      w = (u32x4){cvtpk(p1[0], p1[1]), cvtpk(p1[2], p1[3]), cvtpk(p1[4], p1[5]), cvtpk(p1[6], p1[7])}; pa[2] = __builtin_bit_cast(bf16x8, w);
      w = (u32x4){cvtpk(p1[8], p1[9]), cvtpk(p1[10], p1[11]), cvtpk(p1[12], p1[13]), cvtpk(p1[14], p1[15])}; pa[3] = __builtin_bit_cast(bf16x8, w); }
    DSB();
#pragma unroll
    for (int i = 8; i < 16; ++i) { PVSTEP(i); DSB(); }
    lsum += (s0 + s1) + (s2 + s3);
#undef PVSTEP
#undef KADDR
#undef VADDR
}
__device__ __forceinline__ void diff_attn_phase(LAS unsigned char* lds, int vcu, int G, const bf16* Qt, const bf16* Kt, const bf16* Vt, const bf16* Gt, bf16* Ot,
                                                const float* qg, const float* kg, const float* lamp, const float* subg) {
    int tid_ = threadIdx.x; asm volatile("" : "+v"(tid_)); const int tid = tid_, lane = tid & 63, w = __builtin_amdgcn_readfirstlane(tid >> 6), r32 = lane & 31, hi = lane >> 5;
    const int c = w >> 2, jw = w & 3;
    float lam, post, negm;
    { float a = lamp[lane] * lamp[64 + lane], bb = lamp[128 + lane] * lamp[192 + lane]; a = wave_sum(a); bb = wave_sum(bb);
      const float lam_init = 0.8f - 0.6f * expf(-0.3f); lam = expf(a) - expf(bb) + lam_init; post = 1.0f - lam_init;
      const float gq = wave_max(fabsf(qg[lane])), gk = wave_max(fabsf(kg[lane])); negm = -(8.0f * gq * gk * LOG2E); }
    const KVMap map = kv_map(w, lane);
    const LAS unsigned char* kfb = lds + c * 8448 + hi * 1056 + r32 * 16;
    const LAS unsigned char* vfb = lds + 17408 + (4 * hi + ((lane & 15) >> 2)) * 64 + ((lane >> 4) & 1) * 32 + (lane & 3) * 8;
    LAS float* E = (LAS float*)lds;
    LAS float* wsf = (LAS float*)(lds + DIFF_WSF) + w * 64;
    for (int pi = vcu; pi < 512; pi += G) {
        const int bh = pi >> 5, jj = pi & 31, b = bh >> 3, h = bh & 7;
        const size_t rowbase = (size_t)b * SEQ; const int col0 = h * 128;
        for (int uu = 0; uu < 2; ++uu) {
            const int qb = uu ? 63 - jj : jj, q0 = qb * 128, q0w = q0 + 32 * jw, qrow = q0w + r32, NTL = 2 * qb + 2;
            bf16x8 qr[4];
#pragma unroll
            for (int d0 = 0; d0 < 4; ++d0) qr[d0] = *(const bf16x8*)(Qt + (rowbase + qrow) * DM + col0 + c * 64 + d0 * 16 + hi * 8);
            f32x16 o[4];
#pragma unroll
            for (int r = 0; r < 16; ++r) { o[0][r] = 0.f; o[1][r] = 0.f; o[2][r] = 0.f; o[3][r] = 0.f; }
            float lsum = 0.f;
            KVStage st;
            kv_gload(st, Kt + rowbase * DM + col0, Vt + rowbase * DM + col0, map);
            kv_lstore(st, lds, map);
            kv_gload(st, Kt + (rowbase + 64) * DM + col0, Vt + (rowbase + 64) * DM + col0, map);
            kv_lstore(st, lds + 34048, map);
            __builtin_amdgcn_s_waitcnt(0);
            __syncthreads();
            const int NS = NTL >> 1;
            for (int u = 0; u < NS; ++u) {
                const int cb = (u & 1) * 68096, nb = cb ^ 68096; const bool more = (u + 1 < NS);
                if (more) kv_gload(st, Kt + (rowbase + 64 * (2 * u + 2)) * DM + col0, Vt + (rowbase + 64 * (2 * u + 2)) * DM + col0, map);
#pragma unroll
                for (int j = 0; j < 2; ++j) {
                    const int t = 2 * u + j;
                    if (64 * t <= q0w + 31) { int lim = qrow - 64 * t - 4 * hi; asm volatile("" : "+v"(lim));
                        diff_tile(o, lsum, kfb + cb + j * 34048, vfb + cb + j * 34048, qr, negm, 64 * t + 63 > q0w, lim); }
                    if (more) { kv_lstore(st, lds + nb + j * 34048, map);
                        if (j == 0) kv_gload(st, Kt + (rowbase + 64 * (2 * u + 3)) * DM + col0, Vt + (rowbase + 64 * (2 * u + 3)) * DM + col0, map); }
                }
                __syncthreads();
            }
            { auto rr = __builtin_amdgcn_permlane32_swap(__float_as_uint(lsum), __float_as_uint(lsum), false, false); lsum = __uint_as_float(rr[0]) + __uint_as_float(rr[1]); }
            if (hi == 0) wsf[r32] = (c ? lam : 1.0f) / lsum;
            float rli[16];
#pragma unroll
            for (int r = 0; r < 16; ++r) rli[r] = wsf[crow(r, hi)];
            if (c == 1) {
#pragma unroll
                for (int db = 0; db < 4; ++db)
#pragma unroll
                    for (int r = 0; r < 16; ++r) E[(32 * jw + crow(r, hi)) * 132 + 32 * db + r32] = o[db][r] * rli[r];
            }
            __syncthreads();
            if (c == 0) {
#pragma unroll
                for (int db = 0; db < 4; ++db)
#pragma unroll
                    for (int r = 0; r < 16; ++r) { LAS float* e = E + (32 * jw + crow(r, hi)) * 132 + 32 * db + r32; *e = o[db][r] * rli[r] - *e; }
            }
            __syncthreads();
            row_pass<1>(E, tid, rowbase + q0, col0, Gt, Ot, subg, post);
            __syncthreads();
        }
    }
}

__device__ __forceinline__ unsigned f2bf(float f) { unsigned u = __builtin_bit_cast(unsigned, f); return (u + 0x7fffu + ((u >> 16) & 1u)) >> 16; }
__device__ __forceinline__ unsigned pk2(float lo, float hi) { return f2bf(lo) | (f2bf(hi) << 16); }
__device__ __forceinline__ void p0_transpose_item(const float* W, const float* g, int K, int N, bf16* WT, int row_off, LAS float* scr, int item, int lane, int perm_below = 0) {
    const int nblk = N / 32, kb = item / nblk, nb = item % nblk, k0 = 64 * kb, n0 = 32 * nb;
    const int np0 = (n0 < perm_below) ? ((n0 & ~255) + 128 * ((n0 >> 5) & 1) + 32 * ((n0 & 255) >> 6)) : n0;
    float wv[32];
#pragma unroll
    for (int i = 0; i < 32; ++i) { const int kk = 2 * i + (lane >> 5); const float gv = g ? g[k0 + kk] : 1.0f; wv[i] = W[(size_t)(k0 + kk) * N + n0 + (lane & 31)] * gv; }
#pragma unroll
    for (int i = 0; i < 32; ++i) { const int kk = 2 * i + (lane >> 5); scr[kk * 33 + (lane & 31)] = wv[i]; }
    asm volatile("s_waitcnt lgkmcnt(0)" ::: "memory");
    const int cc = lane & 7;
#pragma unroll
    for (int j = 0; j < 4; ++j) { const int n = (lane >> 3) + 8 * j; const LAS float* s = scr + (8 * cc) * 33 + n;
        u32x4 o; o.x = pk2(s[0 * 33], s[1 * 33]); o.y = pk2(s[2 * 33], s[3 * 33]); o.z = pk2(s[4 * 33], s[5 * 33]); o.w = pk2(s[6 * 33], s[7 * 33]);
        *(u32x4*)(WT + (size_t)(row_off + np0 + n) * K + k0 + 8 * cc) = o; }
    asm volatile("s_waitcnt lgkmcnt(0)" ::: "memory");
}
__device__ __forceinline__ void rms_row_to_bf16(const float* xrow, bf16* orow, int lane) {
    const f32x4* xr = (const f32x4*)xrow + lane;
    f32x4 v[4]; float s = 0.f;
#pragma unroll
    for (int j = 0; j < 4; ++j) { v[j] = xr[64 * j]; s += (v[j].x * v[j].x + v[j].y * v[j].y) + (v[j].z * v[j].z + v[j].w * v[j].w); }
    const float rstd = 1.0f / sqrtf(wave_sum(s) * (1.0f / DM) + EPS);
    unsigned long long* o8 = (unsigned long long*)orow + lane;
#pragma unroll
    for (int j = 0; j < 4; ++j) o8[64 * j] = (unsigned long long)pk2(v[j].x * rstd, v[j].y * rstd) | ((unsigned long long)pk2(v[j].z * rstd, v[j].w * rstd) << 32);
}
__device__ __forceinline__ void qk_norm_rope_item(bf16* Kraw, bf16* Qraw, const float* kg, const float* qg, const f32x2* rope, int idx) {
    const int row = idx >> 5, c32 = idx & 31; const bool isq = c32 >= 16;
    bf16* p = (isq ? Qraw : Kraw) + (size_t)row * DM + (c32 & 15) * 64; const float* g = isq ? qg : kg;
    u32x4 raw[8];
#pragma unroll
    for (int i = 0; i < 8; ++i) raw[i] = *(const u32x4*)(p + 8 * i);
    float v[64]; float ss = 0.f;
#pragma unroll
    for (int i = 0; i < 8; ++i)
#pragma unroll
        for (int j = 0; j < 4; ++j) { const float lo = __uint_as_float(raw[i][j] << 16), hi = __uint_as_float(raw[i][j] & 0xffff0000u); v[8 * i + 2 * j] = lo; v[8 * i + 2 * j + 1] = hi; ss += lo * lo + hi * hi; }
    const float rstd = (isq ? QS : 1.0f) / sqrtf(ss * (1.0f / 64.0f) + EPS);
    const f32x2* cs = rope + (size_t)row * 32;
#pragma unroll
    for (int i = 0; i < 32; ++i) { const f32x2 t = cs[i]; const float t1 = v[i] * rstd * g[i], t2 = v[i + 32] * rstd * g[i + 32]; v[i] = t1 * t.x - t2 * t.y; v[i + 32] = t2 * t.x + t1 * t.y; }
#pragma unroll
    for (int i = 0; i < 8; ++i) { u32x4 o;
#pragma unroll
        for (int j = 0; j < 4; ++j) o[j] = cvtpk(v[8 * i + 2 * j], v[8 * i + 2 * j + 1]);
        *(u32x4*)(p + 8 * i) = o; }
}

struct Args { const float* x; const int* pos; const float* a_norm_g; const float* a_w_in; const float* a_w_out; const float* kv_norm_g; const float* w_kv; const float* k_norm_g;
              const float* b_norm_g; const float* b_w_in; const float* b_q_norm_g; const float* b_lambda; const float* b_subln_g; const float* b_w_out; float* out; unsigned char* ws; int cg_seams; int pad_; };

__global__ void __launch_bounds__(NTHR, 2) yoco_fwd(Args a) {
    extern __shared__ __attribute__((aligned(16))) unsigned char lds_raw[];
    LAS unsigned char* lds = (LAS unsigned char*)lds_raw;
    cg::grid_group grid = cg::this_grid();
    const int tid = threadIdx.x, lane = tid & 63, wave = __builtin_amdgcn_readfirstlane(tid >> 6);
    const int G = gridDim.x, bx = blockIdx.x, vcu = (G % 8 == 0) ? (bx % 8) * (G / 8) + bx / 8 : bx;
    unsigned char* ws = a.ws;
    if (tid < 16) ((LAS unsigned*)(lds + LDS_CTL))[tid] = 0u;
    __syncthreads();
    const XcdBarrier bar = xcd_barrier_post((unsigned*)(ws + WS_BAR), (volatile LAS unsigned*)(lds + LDS_CTL));
    float* sumsq = (float*)(ws + WS_SUMSQ); unsigned* rope = (unsigned*)(ws + WS_ROPE);
    bf16* WinA = (bf16*)(ws + WS_WINA); bf16* WoutA = (bf16*)(ws + WS_WOUTA); bf16* WB = (bf16*)(ws + WS_WB); bf16* WoutB = (bf16*)(ws + WS_WOUTB);
    bf16* XA = (bf16*)(ws + WS_XA); bf16* T0 = (bf16*)(ws + WS_T); bf16* T1 = T0 + TSTRIDE; bf16* T2 = T1 + TSTRIDE; bf16* T3 = T2 + TSTRIDE; bf16* OB = (bf16*)(ws + WS_O);

    {
        LAS float* scr = (LAS float*)(lds + wave * 16384);
        const int gw = vcu * NWAVES + wave, NGW = G * NWAVES;
        constexpr int I_INA = 16 * 128, I_OUT = 16 * 32, I_KV = 16 * 64, I_BIN = 16 * 64;
        constexpr int NITEMS = I_INA + I_OUT + I_KV + I_BIN + I_OUT;
        for (int it = gw; it < NITEMS; it += NGW) {
            int r = it;
            if (r < I_INA) { p0_transpose_item(a.a_w_in, a.a_norm_g, DM, 4096, WinA, 0, scr, r, lane); continue; } r -= I_INA;
            if (r < I_OUT) { p0_transpose_item(a.a_w_out, nullptr, DM, DM, WoutA, 0, scr, r, lane); continue; } r -= I_OUT;
            if (r < I_KV) { p0_transpose_item(a.w_kv, a.kv_norm_g, DM, 2048, WB, 0, scr, r, lane, 1024); continue; } r -= I_KV;
            if (r < I_BIN) { p0_transpose_item(a.b_w_in, a.b_norm_g, DM, 2048, WB, 2048, scr, r, lane, 1024); continue; } r -= I_BIN;
            p0_transpose_item(a.b_w_out, nullptr, DM, DM, WoutB, 0, scr, r, lane);
        }
        for (int m = gw; m < M; m += 2 * NGW) {
            const f32x4* xa0 = (const f32x4*)(a.x + (size_t)m * DM) + lane; const int m1 = (m + NGW < M) ? m + NGW : m; const f32x4* xa1 = (const f32x4*)(a.x + (size_t)m1 * DM) + lane;
            f32x4 v0[4], v1[4]; float q0 = 0.f, q1 = 0.f;
#pragma unroll
            for (int j = 0; j < 4; ++j) { v0[j] = xa0[64 * j]; v1[j] = xa1[64 * j]; }
#pragma unroll
            for (int j = 0; j < 4; ++j) { q0 += (v0[j].x * v0[j].x + v0[j].y * v0[j].y) + (v0[j].z * v0[j].z + v0[j].w * v0[j].w); q1 += (v1[j].x * v1[j].x + v1[j].y * v1[j].y) + (v1[j].z * v1[j].z + v1[j].w * v1[j].w); }
            const float r0 = 1.0f / sqrtf(wave_sum(q0) * (1.0f / DM) + EPS), r1 = 1.0f / sqrtf(wave_sum(q1) * (1.0f / DM) + EPS);
            unsigned long long* o0 = (unsigned long long*)(XA + (size_t)m * DM) + lane; unsigned long long* o1 = (unsigned long long*)(XA + (size_t)m1 * DM) + lane;
#pragma unroll
            for (int j = 0; j < 4; ++j) { o0[64 * j] = (unsigned long long)pk2(v0[j].x * r0, v0[j].y * r0) | ((unsigned long long)pk2(v0[j].z * r0, v0[j].w * r0) << 32);
                o1[64 * j] = (unsigned long long)pk2(v1[j].x * r1, v1[j].y * r1) | ((unsigned long long)pk2(v1[j].z * r1, v1[j].w * r1) << 32); }
        }
        const int gt = vcu * NTHR + tid, NGT = G * NTHR;
        for (int idx = gt; idx < M * 32; idx += NGT) {
            const int row = idx >> 5, i = idx & 31;
            const float inv = (float)exp2(-(double)i * (13.287712379549449 / 32.0));
            const float ang = (float)a.pos[row] * inv;
            const double ad = (double)ang; const double kq = rint(ad * 0.15915494309189535);
            double rr = fma(-kq, 6.283185307179586, ad); rr = fma(-kq, 2.4492935982947064e-16, rr);
            const float rf = (float)rr;
            rope[idx] = pk2(cosf(rf), sinf(rf));
        }
    }
    if (a.cg_seams) grid.sync(); else xcd_barrier(bar);
    { pg8::Gemm g{XA, WinA, M, 4096, DM}; pg8::StaticOrder S; S.init(M, 4096, G, bx);
      pg8::EpiSplit4 E{T0, TSTRIDE, nullptr, QS, 0, 3};
      pg8::gemm_phase<pg8::EpiSplit4, pg8::StaticOrder, true, true>(lds, g, S, E); }
    if (a.cg_seams) grid.sync(); else xcd_barrier(bar);
    stick_attn_phase(lds, vcu, G, T0, T1, T2, T3, OB);
    if (a.cg_seams) grid.sync(); else xcd_barrier(bar);
    { pg8::Gemm g{OB, WoutA, M, DM, DM}; pg8::StaticOrder S; S.init(M, DM, G, bx);
      pg8::EpiRes E{a.x, nullptr, XA, sumsq};
      pg8::gemm_phase<pg8::EpiRes, pg8::StaticOrder, true, true>(lds, g, S, E); }
    if (a.cg_seams) grid.sync(); else xcd_barrier(bar);
    { pg8::Gemm g{XA, WB, M, 4096, DM}; pg8::StaticOrder S; S.init(M, 4096, G, bx);
      pg8::EpiB E{T0, TSTRIDE, sumsq, a.k_norm_g, a.b_q_norm_g, (const unsigned*)rope, QS, a.b_subln_g, 1.0f - (0.8f - 0.6f * expf(-0.3f))};
      pg8::gemm_phase<pg8::EpiB, pg8::StaticOrder, true, true>(lds, g, S, E); }
    if (a.cg_seams) grid.sync(); else xcd_barrier(bar);
    diff_attn_phase(lds, vcu, G, T2, T0, T1, T3, OB, a.b_q_norm_g, a.k_norm_g, a.b_lambda, a.b_subln_g);
    if (a.cg_seams) grid.sync(); else xcd_barrier(bar);
    { pg8::Gemm g{OB, WoutB, M, DM, DM}; pg8::StaticOrder S; S.init(M, DM, G, bx);
      pg8::EpiResBf E{XA, a.out};
      pg8::gemm_phase<pg8::EpiResBf, pg8::StaticOrder, true, true>(lds, g, S, E); }
}
}

extern "C" void kernel_launch(void* const* d_in, const int* in_sizes, int n_in, void* d_out, int out_size, void* d_ws, size_t ws_size, hipStream_t stream) {
    static int grid = 0;
    if (grid == 0) {
        if (n_in != 14 || in_sizes[0] != mk::M * mk::DM || out_size != mk::M * mk::DM || ws_size < mk::WS_END) { fprintf(stderr, "kernel_launch: unexpected shapes (n_in %d, ws %zu); nothing launched\n", n_in, ws_size); grid = -1; return; }
        int dev = 0, cus = 0, per_cu = 0;
        if (hipGetDevice(&dev) != hipSuccess || hipDeviceGetAttribute(&cus, hipDeviceAttributeMultiprocessorCount, dev) != hipSuccess) { grid = -1; return; }
        if (hipFuncSetAttribute((const void*)mk::yoco_fwd, hipFuncAttributeMaxDynamicSharedMemorySize, mk::LDS_BYTES) != hipSuccess) { fprintf(stderr, "kernel_launch: hipFuncSetAttribute failed\n"); grid = -1; return; }
        if (hipOccupancyMaxActiveBlocksPerMultiprocessor(&per_cu, (const void*)mk::yoco_fwd, mk::NTHR, mk::LDS_BYTES) != hipSuccess || per_cu < 1) { fprintf(stderr, "kernel_launch: occupancy query gave %d\n", per_cu); (void)hipGetLastError(); per_cu = 1; }
        grid = cus * per_cu;
    }
    if (grid < 0) return;
    (void)hipMemsetAsync((char*)d_ws, 0, 512 * 1024, stream);
    mk::Args a{};
    a.x = (const float*)d_in[0]; a.pos = (const int*)d_in[1]; a.a_norm_g = (const float*)d_in[2]; a.a_w_in = (const float*)d_in[3]; a.a_w_out = (const float*)d_in[4];
    a.kv_norm_g = (const float*)d_in[5]; a.w_kv = (const float*)d_in[6]; a.k_norm_g = (const float*)d_in[7]; a.b_norm_g = (const float*)d_in[8]; a.b_w_in = (const float*)d_in[9];
    a.b_q_norm_g = (const float*)d_in[10]; a.b_lambda = (const float*)d_in[11]; a.b_subln_g = (const float*)d_in[12]; a.b_w_out = (const float*)d_in[13];
    a.out = (float*)d_out; a.ws = (unsigned char*)d_ws;
    void* args[] = {&a};
    const hipError_t e = hipLaunchCooperativeKernel((const void*)mk::yoco_fwd, dim3(grid), dim3(mk::NTHR), args, mk::LDS_BYTES, stream);
    if (e != hipSuccess) fprintf(stderr, "kernel_launch: cooperative launch failed: %s (grid %d)\n", hipGetErrorString(e), grid);
}
```

```cpp
#include <hip/hip_runtime.h>
#include <hip/hip_cooperative_groups.h>
#include <cstdio>
#include <cstdint>
#include <cmath>
namespace cg = cooperative_groups;
namespace pg8 {
#define PG8_LAS __attribute__((address_space(3)))
typedef unsigned short bf16_t;
typedef short bf16x8 __attribute__((ext_vector_type(8)));
typedef float f32x4 __attribute__((ext_vector_type(4)));
typedef unsigned u32x4 __attribute__((ext_vector_type(4)));
constexpr int BM = 256, BK = 64, HALF = 128, HTB = HALF * BK * 2  , STAGE_BYTES = 8 * HTB, NXCD = 8, WGM = 8;

__host__ __device__ __forceinline__ int lds_byte(int r, int c) { const int st = (r >> 4) * 2 + (c >> 5), rr = r & 15, cc = c & 31, ob = rr * 64 + cc * 2; return st * 1024 + (ob ^ (((ob >> 9) & 1) << 5)); }
__host__ __device__ __forceinline__ void stage_rc(int b, int& R, int& C) { const int st = b / 1024, sb = b % 1024, swz = sb ^ (((sb >> 9) & 1) << 5); R = (st >> 1) * 16 + swz / 64; C = (st & 1) * 32 + (swz % 64) / 2; }
__host__ __device__ __forceinline__ int perm32(int rho) { const int n = rho >> 4, i = rho & 15; return 8 * (i >> 2) + 4 * n + (i & 3); }

struct Unit { int pm, pn; };
struct Gemm { const bf16_t* A; const bf16_t* Bt; int M, N, K; };

struct StaticOrder {
    int nM, nN, nwg, G, c;
    __host__ __device__ void init(int M, int N, int G_, int c_) { nM = M / BM; nN = N / BM; nwg = nM * nN; G = G_; c = c_; }
    __host__ __device__ bool next(int i, Unit& u) const {
        const long L = (long)i * G + c; if (L >= nwg) return false;
        int wgid = (int)L; { const int q = nwg / NXCD, r = nwg % NXCD, xcd = wgid % NXCD, off = wgid / NXCD; wgid = (xcd < r ? xcd * (q + 1) : r * (q + 1) + (xcd - r) * q) + off; }
        const int nig = WGM * nN, gid = wgid / nig, fm = gid * WGM, gsz = (nM - fm) < WGM ? (nM - fm) : WGM;
        u.pm = fm + ((wgid % nig) % gsz); u.pn = (wgid % nig) / gsz; return true;
    }
    __device__ __forceinline__ void a_ready(const Unit&) const {}
    __device__ __forceinline__ void done(const Unit&) const {}
};

__device__ __forceinline__ unsigned cvt_pk_bf16(float lo, float hi) { unsigned r; asm volatile("v_cvt_pk_bf16_f32 %0, %1, %2" : "=v"(r) : "v"(lo), "v"(hi)); return r; }
typedef float f32x2 __attribute__((ext_vector_type(2)));
__device__ __forceinline__ f32x2 gelu_pk(f32x2 v) {
    const f32x2 av = __builtin_elementwise_abs(v), d = av * 0.2316418882f + 1.0f;
    f32x2 t; t.x = __builtin_amdgcn_rcpf(d.x); t.y = __builtin_amdgcn_rcpf(d.y);
    f32x2 q = t * 0.5307027145f + (-0.7265760135f); q = q * t + 0.7107068705f; q = q * t + (-0.142248368f); q = q * t + 0.127414796f; q = q * t;
    const f32x2 s = (v * v) * (-0.72134752044f);
    f32x2 e; e.x = __builtin_amdgcn_exp2f(s.x); e.y = __builtin_amdgcn_exp2f(s.y);
    const f32x2 m = v * (q * e), r = v - m;
    f32x2 o; o.x = v.x < 0.f ? m.x : r.x; o.y = v.y < 0.f ? m.y : r.y; return o;
}

template <int ACT  > struct EpiBf16 {
    static constexpr bool PERM = true, AFTER_DRAIN = false; static_assert(ACT == 0 || ACT == 1, "EpiBf16: ACT is 0 (none) or 1 (gelu_pk)");
    bf16_t* O; int ldc; const float* bias; int split_cols; size_t split_stride; float scale0;
    __device__ __forceinline__ void operator()(const f32x4 (&acc)[2][2][4][2], const Unit& u, int wr, int wc, int fr, int fq) const {
        const int row0 = u.pm * BM + wr * 64 + fr; int colt = u.pn * BM; bf16_t* base = O;
        float sc = 1.f; if (split_cols) { const int t = colt / split_cols; base += (size_t)t * split_stride; colt -= t * split_cols; if (t == 0) sc = scale0; }
        const int col0 = colt + wc * 32 + 8 * fq, bcol0 = u.pn * BM + wc * 32 + 8 * fq;
        f32x4 bv[2][2];
#pragma unroll
        for (int bj = 0; bj < 2; ++bj)
#pragma unroll
            for (int n = 0; n < 2; ++n) bv[bj][n] = bias ? *(const f32x4*)(bias + bcol0 + bj * HALF + 4 * n) : (f32x4){0.f, 0.f, 0.f, 0.f};
#pragma unroll
        for (int ai = 0; ai < 2; ++ai)
#pragma unroll
            for (int m = 0; m < 4; ++m) { bf16_t* rowp = base + (size_t)(row0 + ai * HALF + m * 16) * ldc + col0;
#pragma unroll
                for (int bj = 0; bj < 2; ++bj) { f32x4 v0 = acc[ai][bj][m][0] + bv[bj][0], v1 = acc[ai][bj][m][1] + bv[bj][1];
                    if (ACT == 1) { f32x2 a = gelu_pk((f32x2){v0[0], v0[1]}), b = gelu_pk((f32x2){v0[2], v0[3]}), c = gelu_pk((f32x2){v1[0], v1[1]}), d = gelu_pk((f32x2){v1[2], v1[3]});
                        v0 = (f32x4){a.x, a.y, b.x, b.y}; v1 = (f32x4){c.x, c.y, d.x, d.y}; }
                    v0 = v0 * sc; v1 = v1 * sc; u32x4 w; w.x = cvt_pk_bf16(v0[0], v0[1]); w.y = cvt_pk_bf16(v0[2], v0[3]); w.z = cvt_pk_bf16(v1[0], v1[1]); w.w = cvt_pk_bf16(v1[2], v1[3]);
                    *(u32x4*)(rowp + bj * HALF) = w; } }
    }
};
template <class Epi, class Sched, bool ALIGN_EPI = false, bool SP2 = false>
__device__ __forceinline__ void gemm_phase(PG8_LAS unsigned char* lds, const Gemm g, const Sched& S, const Epi& E) {
    int tid_ = threadIdx.x; asm volatile("" : "+v"(tid_)); const int tid = tid_, wid = __builtin_amdgcn_readfirstlane(tid >> 6), lane = tid & 63, wr = wid >> 2, wc = wid & 3, fr = lane & 15, fq = lane >> 4;
    const int K = g.K, nt = K / BK;
    unsigned voffA[2], voffB[2];
#pragma unroll
    for (int i = 0; i < 2; ++i) { int R, C; stage_rc(tid * 16 + i * 8192, R, C); const int Rb = Epi::PERM ? ((R & ~31) + perm32(R & 31)) : R;
        voffA[i] = (unsigned)(R * K + C) * 2u; voffB[i] = (unsigned)(Rb * K + C) * 2u; }
    const size_t kstep = (size_t)(BK * 2);
    const size_t hstep = (size_t)HALF * K * 2;
    const size_t tstep = 2 * hstep;
    const unsigned ldsw = (unsigned)wid * 1024u;
    const int aoff = lds_byte(wr * 64 + fr, fq * 8), boff = lds_byte(wc * 32 + fr, fq * 8);
#define PG8_SA(b, h) (((b) * 2 + (h)) * HTB)
#define PG8_SB(b, h) ((4 + (b) * 2 + (h)) * HTB)
#define PG8_STAGE(bufoff, gbase, voff) do { _Pragma("unroll") for (int _i = 0; _i < 2; ++_i) \
        __builtin_amdgcn_global_load_lds((const unsigned*)((const char*)(gbase) + (voff)[_i]), (PG8_LAS unsigned*)(lds + (bufoff) + ldsw + _i * 8192), 16, 0, 0); } while (0)
#define PG8_LDA(dst, b, h) do { _Pragma("unroll") for (int m = 0; m < 4; ++m) _Pragma("unroll") for (int k = 0; k < 2; ++k) dst[m][k] = *(const PG8_LAS bf16x8*)(lds + PG8_SA(b, h) + aoff + m * 2048 + k * 1024); } while (0)
#define PG8_LDB(dst, b, h) do { _Pragma("unroll") for (int n = 0; n < 2; ++n) _Pragma("unroll") for (int k = 0; k < 2; ++k) dst[n][k] = *(const PG8_LAS bf16x8*)(lds + PG8_SB(b, h) + boff + n * 2048 + k * 1024); } while (0)
#define PG8_MMA(ai, bj, At, Bt) do { __builtin_amdgcn_s_setprio(1); _Pragma("unroll") for (int m = 0; m < 4; ++m) _Pragma("unroll") for (int n = 0; n < 2; ++n) _Pragma("unroll") for (int k = 0; k < 2; ++k) \
        acc[ai][bj][m][n] = __builtin_amdgcn_mfma_f32_16x16x32_bf16(Bt[n][k], At[m][k], acc[ai][bj][m][n], 0, 0, 0); __builtin_amdgcn_s_setprio(0); } while (0)
#define PG8_WAIT_V(n) asm volatile("s_waitcnt vmcnt(" #n ")" ::: "memory")
#define PG8_WAIT_L(n) asm volatile("s_waitcnt lgkmcnt(" #n ")" ::: "memory")
#define PG8_BAR __builtin_amdgcn_s_barrier()
#define PG8_SCHED __builtin_amdgcn_sched_barrier(0)
    Unit cur, nxt; int ui = 0;
    if (!S.next(0, cur)) return;
    f32x4 acc[2][2][4][2];
#pragma unroll
    for (int a = 0; a < 2; ++a)
#pragma unroll
        for (int b = 0; b < 2; ++b)
#pragma unroll
            for (int m = 0; m < 4; ++m)
#pragma unroll
                for (int n = 0; n < 2; ++n) acc[a][b][m][n] = (f32x4){0.f, 0.f, 0.f, 0.f};
    bf16x8 At[4][2], B0[2][2], B1[2][2];
    const char* cA = (const char*)g.A + (size_t)cur.pm * tstep; const char* cB = (const char*)g.Bt + (size_t)cur.pn * tstep;
    S.a_ready(cur);
    if constexpr (SP2) {
        PG8_STAGE(PG8_SB(0, 0), cB, voffB); PG8_STAGE(PG8_SB(0, 1), cB + hstep, voffB); PG8_STAGE(PG8_SA(0, 0), cA, voffA); PG8_STAGE(PG8_SA(0, 1), cA + hstep, voffA);
        if (wr == 1) PG8_BAR;
        PG8_WAIT_V(2); PG8_BAR;
        PG8_STAGE(PG8_SB(1, 0), cB + kstep, voffB); PG8_STAGE(PG8_SA(1, 0), cA + kstep, voffA); PG8_STAGE(PG8_SB(1, 1), cB + hstep + kstep, voffB);
        PG8_WAIT_V(6); PG8_BAR;
    } else {
        PG8_STAGE(PG8_SB(0, 0), cB, voffB); PG8_STAGE(PG8_SA(0, 0), cA, voffA); PG8_STAGE(PG8_SB(0, 1), cB + hstep, voffB); PG8_STAGE(PG8_SA(0, 1), cA + hstep, voffA);
        if (wr == 1) PG8_BAR;
        PG8_WAIT_V(4); PG8_BAR;
        PG8_STAGE(PG8_SB(1, 0), cB + kstep, voffB); PG8_STAGE(PG8_SA(1, 0), cA + kstep, voffA); PG8_STAGE(PG8_SB(1, 1), cB + hstep + kstep, voffB);
        PG8_WAIT_V(6); PG8_BAR;
    }
    for (;;) {
        const bool has_next = S.next(ui + 1, nxt);
        const char* nA = has_next ? (const char*)g.A + (size_t)nxt.pm * tstep : cA; const char* nB = has_next ? (const char*)g.Bt + (size_t)nxt.pn * tstep : cB;
        for (int t = 0; t < nt; t += 2) {
            const bool last = (t == nt - 2);
            const char* a1 = cA + (size_t)(t + 1) * kstep;
            const char* a2 = last ? nA : cA + (size_t)(t + 2) * kstep; const char* b2 = last ? nB : cB + (size_t)(t + 2) * kstep;
            const char* a3 = a2 + kstep; const char* b3 = b2 + kstep;
            if (last && has_next) S.a_ready(nxt);
            if constexpr (SP2) {
            PG8_LDB(B0, 0, 0); PG8_LDB(B1, 0, 1); PG8_SCHED; PG8_LDA(At, 0, 0); PG8_STAGE(PG8_SA(1, 1), a1 + hstep, voffA);
            PG8_WAIT_V(8); PG8_WAIT_L(0); PG8_BAR; PG8_MMA(0, 0, At, B0); PG8_MMA(0, 1, At, B1); PG8_BAR; PG8_SCHED;
            PG8_LDA(At, 0, 1); PG8_STAGE(PG8_SB(0, 0), b2, voffB); PG8_STAGE(PG8_SB(0, 1), b2 + hstep, voffB); PG8_STAGE(PG8_SA(0, 0), a2, voffA);
            PG8_WAIT_V(8); PG8_WAIT_L(0); PG8_BAR; PG8_MMA(1, 0, At, B0); PG8_MMA(1, 1, At, B1); PG8_BAR; PG8_SCHED;
            PG8_LDB(B0, 1, 0); PG8_LDB(B1, 1, 1); PG8_SCHED; PG8_LDA(At, 1, 0); PG8_STAGE(PG8_SA(0, 1), a2 + hstep, voffA);
            PG8_WAIT_V(8); PG8_WAIT_L(0); PG8_BAR; PG8_MMA(0, 0, At, B0); PG8_MMA(0, 1, At, B1); PG8_BAR; PG8_SCHED;
            PG8_LDA(At, 1, 1); PG8_STAGE(PG8_SB(1, 0), b3, voffB); PG8_STAGE(PG8_SB(1, 1), b3 + hstep, voffB); PG8_STAGE(PG8_SA(1, 0), a3, voffA);
            PG8_WAIT_V(8); PG8_WAIT_L(0); PG8_BAR; PG8_MMA(1, 0, At, B0); PG8_MMA(1, 1, At, B1); PG8_BAR; PG8_SCHED;
            } else {
            PG8_LDB(B0, 0, 0); PG8_SCHED; PG8_LDA(At, 0, 0); PG8_STAGE(PG8_SA(1, 1), a1 + hstep, voffA);
            PG8_WAIT_L(8); PG8_BAR; PG8_WAIT_L(0); PG8_MMA(0, 0, At, B0); PG8_BAR; PG8_SCHED;
            PG8_LDB(B1, 0, 1); PG8_STAGE(PG8_SB(0, 0), b2, voffB);
            PG8_BAR; PG8_WAIT_L(0); PG8_MMA(0, 1, At, B1); PG8_BAR;
            PG8_LDA(At, 0, 1); PG8_STAGE(PG8_SA(0, 0), a2, voffA);
            PG8_BAR; PG8_WAIT_L(0); PG8_MMA(1, 0, At, B0); PG8_BAR; PG8_SCHED;
            PG8_STAGE(PG8_SB(0, 1), b2 + hstep, voffB);
            PG8_WAIT_V(6); PG8_BAR; PG8_MMA(1, 1, At, B1); PG8_BAR;
            PG8_LDB(B0, 1, 0); PG8_SCHED; PG8_LDA(At, 1, 0); PG8_STAGE(PG8_SA(0, 1), a2 + hstep, voffA);
            PG8_WAIT_L(8); PG8_BAR; PG8_WAIT_L(0); PG8_MMA(0, 0, At, B0); PG8_BAR; PG8_SCHED;
            PG8_LDB(B1, 1, 1); PG8_STAGE(PG8_SB(1, 0), b3, voffB);
            PG8_BAR; PG8_WAIT_L(0); PG8_MMA(0, 1, At, B1); PG8_BAR;
            PG8_LDA(At, 1, 1); PG8_STAGE(PG8_SA(1, 0), a3, voffA);
            PG8_BAR; PG8_WAIT_L(0); PG8_MMA(1, 0, At, B0); PG8_BAR; PG8_SCHED;
            PG8_STAGE(PG8_SB(1, 1), b3 + hstep, voffB);
            PG8_WAIT_V(6); PG8_BAR; PG8_MMA(1, 1, At, B1); PG8_BAR;
            }
        }
        if constexpr (ALIGN_EPI) { if (wr == 0) PG8_BAR; }
        if constexpr (!Epi::AFTER_DRAIN) { E(acc, cur, wr, wc, fr, fq); S.done(cur); }
        if (!has_next) break;
#pragma unroll
        for (int a = 0; a < 2; ++a)
#pragma unroll
            for (int b = 0; b < 2; ++b)
#pragma unroll
                for (int m = 0; m < 4; ++m)
#pragma unroll
                    for (int n = 0; n < 2; ++n) acc[a][b][m][n] = (f32x4){0.f, 0.f, 0.f, 0.f};
        cur = nxt; cA = nA; cB = nB; ++ui;
        if constexpr (ALIGN_EPI) { if (wr == 1) PG8_BAR; }
    }
    PG8_WAIT_V(0);
    if constexpr (!ALIGN_EPI) { if (wr == 0) PG8_BAR; }
    PG8_BAR;
    if constexpr (Epi::AFTER_DRAIN) { E.fused(acc, cur, wr, wc, fr, fq, lds, wid, lane); S.done(cur); }
#undef PG8_SA
#undef PG8_SB
#undef PG8_STAGE
#undef PG8_LDA
#undef PG8_LDB
#undef PG8_MMA
#undef PG8_WAIT_V
#undef PG8_WAIT_L
#undef PG8_BAR
#undef PG8_SCHED
}
}
namespace pg8 {
__device__ __forceinline__ float silu_f(float x) { return x * __builtin_amdgcn_rcpf(1.0f + __builtin_amdgcn_exp2f(-1.4426950408889634f * x)); }
struct EpiSplit4 {
    static constexpr bool PERM = true, AFTER_DRAIN = false;
    bf16_t* O; size_t split_stride; const float* sumsq; float qscale; int q_split, gate_split;
    __device__ __forceinline__ void operator()(const f32x4 (&acc)[2][2][4][2], const Unit& u, int wr, int wc, int fr, int fq) const {
        const int row0 = u.pm * BM + wr * 64 + fr; int colt = u.pn * BM; const int t = colt >> 10; colt &= 1023;
        bf16_t* base = O + (size_t)t * split_stride; const int col0 = colt + wc * 32 + 8 * fq;
        const float ts = (t == q_split) ? qscale : 1.f; const bool gate = (t == gate_split);
#pragma unroll
        for (int ai = 0; ai < 2; ++ai)
#pragma unroll
            for (int m = 0; m < 4; ++m) { const int row = row0 + ai * HALF + m * 16; float rs = ts;
                if (sumsq) rs *= 1.0f / sqrtf(sumsq[row] * (1.0f / 1024.0f) + 1e-6f);
                bf16_t* rowp = base + (size_t)row * 1024 + col0;
#pragma unroll
                for (int bj = 0; bj < 2; ++bj) { f32x4 v0 = acc[ai][bj][m][0] * rs, v1 = acc[ai][bj][m][1] * rs;
                    if (gate) { v0 = (f32x4){silu_f(v0[0]), silu_f(v0[1]), silu_f(v0[2]), silu_f(v0[3])}; v1 = (f32x4){silu_f(v1[0]), silu_f(v1[1]), silu_f(v1[2]), silu_f(v1[3])}; }
                    u32x4 w; w.x = cvt_pk_bf16(v0[0], v0[1]); w.y = cvt_pk_bf16(v0[2], v0[3]); w.z = cvt_pk_bf16(v1[0], v1[1]); w.w = cvt_pk_bf16(v1[2], v1[3]);
                    *(u32x4*)(rowp + bj * HALF) = w; } }
    }
};
struct EpiRes {
    static constexpr bool PERM = true, AFTER_DRAIN = false;
    const float* base; float* out; bf16_t* xa; float* sumsq;
    __device__ __forceinline__ void load_batch(f32x4 (&b)[2][2][2], int q, int row0, int col0) const {
#pragma unroll
        for (int mm = 0; mm < 2; ++mm)
#pragma unroll
            for (int bj = 0; bj < 2; ++bj) { const size_t off = (size_t)(row0 + (q >> 1) * HALF + (2 * (q & 1) + mm) * 16) * 1024 + col0 + bj * HALF; b[mm][bj][0] = *(const f32x4*)(base + off); b[mm][bj][1] = *(const f32x4*)(base + off + 4); }
    }
    __device__ __forceinline__ void store_batch(const f32x4 (&b)[2][2][2], const f32x4 (&acc)[2][2][4][2], int q, int row0, int col0, int fq, int pslot) const {
#pragma unroll
        for (int mm = 0; mm < 2; ++mm) { const int ai = q >> 1, m = 2 * (q & 1) + mm; const int row = row0 + ai * HALF + m * 16; const size_t off = (size_t)row * 1024 + col0; float ss = 0.f;
#pragma unroll
            for (int bj = 0; bj < 2; ++bj) { const f32x4 v0 = b[mm][bj][0] + acc[ai][bj][m][0], v1 = b[mm][bj][1] + acc[ai][bj][m][1];
                if (out) { *(f32x4*)(out + off + bj * HALF) = v0; *(f32x4*)(out + off + bj * HALF + 4) = v1; }
                ss += (v0[0] * v0[0] + v0[1] * v0[1]) + (v0[2] * v0[2] + v0[3] * v0[3]) + (v1[0] * v1[0] + v1[1] * v1[1]) + (v1[2] * v1[2] + v1[3] * v1[3]);
                if (xa) { u32x4 w; w.x = cvt_pk_bf16(v0[0], v0[1]); w.y = cvt_pk_bf16(v0[2], v0[3]); w.z = cvt_pk_bf16(v1[0], v1[1]); w.w = cvt_pk_bf16(v1[2], v1[3]);
                    *(u32x4*)(xa + off + bj * HALF) = w; } }
            if (sumsq) { ss += __shfl_xor(ss, 16); ss += __shfl_xor(ss, 32); if (fq == 0) atomicAdd(sumsq + row, ss); } }
    }
    __device__ __forceinline__ void operator()(const f32x4 (&acc)[2][2][4][2], const Unit& u, int wr, int wc, int fr, int fq) const {
        const int row0 = u.pm * BM + wr * 64 + fr; const int col0 = u.pn * BM + wc * 32 + 8 * fq; const int pslot = u.pn * 4 + wc;
        f32x4 b0[2][2][2], b1[2][2][2];
        load_batch(b0, 0, row0, col0);
        load_batch(b1, 1, row0, col0); store_batch(b0, acc, 0, row0, col0, fq, pslot);
        load_batch(b0, 2, row0, col0); store_batch(b1, acc, 1, row0, col0, fq, pslot);
        load_batch(b1, 3, row0, col0); store_batch(b0, acc, 2, row0, col0, fq, pslot);
        store_batch(b1, acc, 3, row0, col0, fq, pslot);
    }
};

struct EpiResBf {
    static constexpr bool PERM = true, AFTER_DRAIN = false;
    const bf16_t* resid; float* out;
    __device__ __forceinline__ void operator()(const f32x4 (&acc)[2][2][4][2], const Unit& u, int wr, int wc, int fr, int fq) const {
        const int row0 = u.pm * BM + wr * 64 + fr; const int col0 = u.pn * BM + wc * 32 + 8 * fq;
        u32x4 r[2][4][2];
#pragma unroll
        for (int ai = 0; ai < 2; ++ai)
#pragma unroll
            for (int m = 0; m < 4; ++m)
#pragma unroll
                for (int bj = 0; bj < 2; ++bj) r[ai][m][bj] = *(const u32x4*)(resid + (size_t)(row0 + ai * HALF + m * 16) * 1024 + col0 + bj * HALF);
#pragma unroll
        for (int ai = 0; ai < 2; ++ai)
#pragma unroll
            for (int m = 0; m < 4; ++m) { const size_t off = (size_t)(row0 + ai * HALF + m * 16) * 1024 + col0;
#pragma unroll
                for (int bj = 0; bj < 2; ++bj) { const u32x4 w = r[ai][m][bj];
                    const f32x4 b0 = {__uint_as_float(w.x << 16), __uint_as_float(w.x & 0xffff0000u), __uint_as_float(w.y << 16), __uint_as_float(w.y & 0xffff0000u)};
                    const f32x4 b1 = {__uint_as_float(w.z << 16), __uint_as_float(w.z & 0xffff0000u), __uint_as_float(w.w << 16), __uint_as_float(w.w & 0xffff0000u)};
                    *(f32x4*)(out + off + bj * HALF) = acc[ai][bj][m][0] + b0; *(f32x4*)(out + off + bj * HALF + 4) = acc[ai][bj][m][1] + b1; } }
    }
};

struct EpiB {
    static constexpr bool PERM = true, AFTER_DRAIN = false;
    bf16_t* O; size_t split_stride; const float* sumsq; const float* kg; const float* qg; const unsigned* rope; float qs; const float* subg; float post;
    __device__ __forceinline__ void operator()(const f32x4 (&acc)[2][2][4][2], const Unit& u, int wr, int wc, int fr, int fq) const {
        const int row0 = u.pm * BM + wr * 64 + fr; int colt = u.pn * BM; const int t = colt >> 10; colt &= 1023;
        bf16_t* base = O + (size_t)t * split_stride;
        float rsv[2][4];
#pragma unroll
        for (int ai = 0; ai < 2; ++ai)
#pragma unroll
            for (int m = 0; m < 4; ++m) rsv[ai][m] = __builtin_amdgcn_rsqf(sumsq[row0 + ai * HALF + m * 16] * (1.0f / 1024.0f) + 1e-6f);
        if (t & 1) {
            const int col0 = colt + wc * 32 + 8 * fq; const bool gate = (t == 3);
            f32x4 sg0 = {1.f, 1.f, 1.f, 1.f}, sg1 = sg0;
            if (gate) { sg0 = *(const f32x4*)(subg + wc * 32 + 8 * fq) * post; sg1 = *(const f32x4*)(subg + wc * 32 + 8 * fq + 4) * post; }
#pragma unroll
            for (int ai = 0; ai < 2; ++ai)
#pragma unroll
                for (int m = 0; m < 4; ++m) { const int row = row0 + ai * HALF + m * 16; const float rs = rsv[ai][m];
                    bf16_t* rowp = base + (size_t)row * 1024 + col0;
#pragma unroll
                    for (int bj = 0; bj < 2; ++bj) { f32x4 v0 = acc[ai][bj][m][0] * rs, v1 = acc[ai][bj][m][1] * rs;
                        if (gate) { v0 = (f32x4){silu_f(v0[0]), silu_f(v0[1]), silu_f(v0[2]), silu_f(v0[3])} * sg0; v1 = (f32x4){silu_f(v1[0]), silu_f(v1[1]), silu_f(v1[2]), silu_f(v1[3])} * sg1; }
                        u32x4 w; w.x = cvt_pk_bf16(v0[0], v0[1]); w.y = cvt_pk_bf16(v0[2], v0[3]); w.z = cvt_pk_bf16(v1[0], v1[1]); w.w = cvt_pk_bf16(v1[2], v1[3]);
                        *(u32x4*)(rowp + bj * HALF) = w; } }
        } else {
            const float* g = (t == 0) ? kg : qg; const float sc = (t == 2) ? qs : 1.0f;
            f32x4 g1[2], g2[2];
#pragma unroll
            for (int n = 0; n < 2; ++n) { g1[n] = *(const f32x4*)(g + 8 * fq + 4 * n) * sc; g2[n] = *(const f32x4*)(g + 32 + 8 * fq + 4 * n) * sc; }
            const int colc = colt + wc * 64 + 8 * fq;
#pragma unroll
            for (int ai = 0; ai < 2; ++ai)
#pragma unroll
                for (int m = 0; m < 4; ++m) { const int row = row0 + ai * HALF + m * 16; const float rs = rsv[ai][m];
                    f32x4 a1[2], a2[2]; float ss = 0.f;
#pragma unroll
                    for (int n = 0; n < 2; ++n) { a1[n] = acc[ai][0][m][n] * rs; a2[n] = acc[ai][1][m][n] * rs;
                        ss += (a1[n][0] * a1[n][0] + a1[n][1] * a1[n][1]) + (a1[n][2] * a1[n][2] + a1[n][3] * a1[n][3]) + (a2[n][0] * a2[n][0] + a2[n][1] * a2[n][1]) + (a2[n][2] * a2[n][2] + a2[n][3] * a2[n][3]); }
                    ss += __shfl_xor(ss, 16); ss += __shfl_xor(ss, 32);
                    const float cr = __builtin_amdgcn_rsqf(ss * (1.0f / 64.0f) + 1e-6f);
                    const u32x4* rp = (const u32x4*)(rope + (size_t)row * 32 + 8 * fq);
                    f32x4 o1[2], o2[2];
#pragma unroll
                    for (int n = 0; n < 2; ++n) { const f32x4 t1 = a1[n] * cr * g1[n], t2 = a2[n] * cr * g2[n]; const u32x4 cw = rp[n];
                        const f32x4 cc = {__uint_as_float(cw.x << 16), __uint_as_float(cw.y << 16), __uint_as_float(cw.z << 16), __uint_as_float(cw.w << 16)};
                        const f32x4 sn = {__uint_as_float(cw.x & 0xffff0000u), __uint_as_float(cw.y & 0xffff0000u), __uint_as_float(cw.z & 0xffff0000u), __uint_as_float(cw.w & 0xffff0000u)};
                        o1[n] = t1 * cc - t2 * sn; o2[n] = t2 * cc + t1 * sn; }
                    bf16_t* rowp = base + (size_t)row * 1024 + colc; u32x4 w;
                    w.x = cvt_pk_bf16(o1[0][0], o1[0][1]); w.y = cvt_pk_bf16(o1[0][2], o1[0][3]); w.z = cvt_pk_bf16(o1[1][0], o1[1][1]); w.w = cvt_pk_bf16(o1[1][2], o1[1][3]); *(u32x4*)(rowp) = w;
                    w.x = cvt_pk_bf16(o2[0][0], o2[0][1]); w.y = cvt_pk_bf16(o2[0][2], o2[0][3]); w.z = cvt_pk_bf16(o2[1][0], o2[1][1]); w.w = cvt_pk_bf16(o2[1][2], o2[1][3]); *(u32x4*)(rowp + 32) = w; }
        }
    }
};
}
namespace mk {
#define LAS __attribute__((address_space(3)))
typedef unsigned short bf16;
typedef unsigned u32x4 __attribute__((ext_vector_type(4)));
typedef float f32x4 __attribute__((ext_vector_type(4)));
typedef float f32x16 __attribute__((ext_vector_type(16)));
typedef short bf16x8 __attribute__((ext_vector_type(8)));
typedef short s16x4 __attribute__((ext_vector_type(4)));
typedef short v4i16_t __attribute__((ext_vector_type(4)));
typedef float f32x2 __attribute__((ext_vector_type(2)));

constexpr int BATCH = 2, SEQ = 8192, DM = 1024, M = BATCH * SEQ, NWAVES = 8, NTHR = 512;
constexpr float EPS = 1e-6f, LOG2E = 1.4426950408889634f, QS = 0.125f * LOG2E;
constexpr float SB_MASS = 2.3283064365386963e-10f;
constexpr size_t MiB = 1u << 20;
constexpr size_t WS_SUMSQ = 0;
constexpr size_t WS_BAR = 256 * 1024;
constexpr size_t WS_ROPE = 1 * MiB;
constexpr size_t WS_WINA = 5 * MiB;
constexpr size_t WS_WOUTA = 13 * MiB;
constexpr size_t WS_WB = 15 * MiB;
constexpr size_t WS_WOUTB = 23 * MiB;
constexpr size_t WS_XA = 32 * MiB;
constexpr size_t WS_T = 64 * MiB;
constexpr size_t WS_O = 192 * MiB;
constexpr size_t WS_END = 224 * MiB;
constexpr size_t TSTRIDE = (size_t)M * DM;
constexpr int RING_BYTES = 131072, LDS_BYTES = 143360;
constexpr int DIFF_WSF = 137216, LDS_CTL = 141312;
constexpr int ATT_WSF = 98304, ATT_FLAGS = 98304 + 2048;

__device__ __forceinline__ int crow(int r, int hi) { return (r & 3) + 8 * (r >> 2) + 4 * hi; }
__device__ __forceinline__ unsigned cvtpk(float lo, float hi) { typedef __bf16 b2 __attribute__((ext_vector_type(2))); f32x2 v = {lo, hi}; b2 b = __builtin_convertvector(v, b2); return __builtin_bit_cast(unsigned, b); }
__device__ __forceinline__ float bf2f(unsigned short b) { return __uint_as_float((unsigned)b << 16); }
__device__ __forceinline__ s16x4 vtr(const LAS unsigned char* p) { return __builtin_bit_cast(s16x4, __builtin_amdgcn_ds_read_tr16_b64_v4i16((LAS v4i16_t*)p)); }
__device__ __forceinline__ float wave_sum(float v) {
#pragma unroll
    for (int o = 1; o < 64; o <<= 1) v += __shfl_xor(v, o);
    return v;
}
__device__ __forceinline__ float wave_max(float v) {
#pragma unroll
    for (int o = 1; o < 64; o <<= 1) v = fmaxf(v, __shfl_xor(v, o));
    return v;
}
#define MFMA32(a, b, c) __builtin_amdgcn_mfma_f32_32x32x16_bf16(a, b, c, 0, 0, 0)

struct KVMap { int kg0, kg1, vg0, vg1, kl0, kl1, vl0, vl1; };
struct KVStage { u32x4 k0, k1, v0, v1; };
__device__ __forceinline__ KVMap kv_map(int w, int lane) {
    KVMap m; const int krow = 16 * (w >> 1) + (lane >> 2); const int kc0 = 8 * (w & 1) + (lane & 3), kc1 = kc0 + 4;
    m.kg0 = krow * DM + 8 * kc0; m.kg1 = krow * DM + 8 * kc1;
    m.kl0 = (kc0 >> 3) * 8448 + (kc0 & 7) * 1056 + krow * 16; m.kl1 = (kc1 >> 3) * 8448 + (kc1 & 7) * 1056 + krow * 16;
    const int vr0 = 8 * w + (lane >> 4), vr1 = vr0 + 4, vch = lane & 15;
    m.vg0 = vr0 * DM + 8 * vch; m.vg1 = vr1 * DM + 8 * vch;
    m.vl0 = 17408 + (vch >> 2) * 4160 + vr0 * 64 + (vch & 3) * 16; m.vl1 = 17408 + (vch >> 2) * 4160 + vr1 * 64 + (vch & 3) * 16;
    return m;
}
__device__ __forceinline__ void kv_gload(KVStage& s, const bf16* Kt, const bf16* Vt, const KVMap& m) {
    s.k0 = *(const u32x4*)(Kt + m.kg0); s.k1 = *(const u32x4*)(Kt + m.kg1); s.v0 = *(const u32x4*)(Vt + m.vg0); s.v1 = *(const u32x4*)(Vt + m.vg1);
}
__device__ __forceinline__ void kv_lstore(const KVStage& s, LAS unsigned char* buf, const KVMap& m) {
    *(LAS u32x4*)(buf + m.kl0) = s.k0; *(LAS u32x4*)(buf + m.kl1) = s.k1; *(LAS u32x4*)(buf + m.vl0) = s.v0; *(LAS u32x4*)(buf + m.vl1) = s.v1;
}
__device__ __forceinline__ void qk_tile(f32x16& p0, f32x16& p1, const LAS unsigned char* kb, const bf16x8 (&qr)[4], float init) {
#pragma unroll
    for (int r = 0; r < 16; ++r) { p0[r] = init; p1[r] = init; }
    constexpr int RD = 3;
    bf16x8 kf[8];
#define KADDR(i) (kb + ((i) >> 1) * 2112 + ((i) & 1) * 512)
#pragma unroll
    for (int i = 0; i < RD; ++i) kf[i] = *(const LAS bf16x8*)KADDR(i);
    __builtin_amdgcn_sched_barrier(0);
#pragma unroll
    for (int i = 0; i < 8; ++i) {
        if (i + RD < 8) kf[i + RD] = *(const LAS bf16x8*)KADDR(i + RD);
        if (i & 1) p1 = MFMA32(kf[i], qr[i >> 1], p1); else p0 = MFMA32(kf[i], qr[i >> 1], p0);
        __builtin_amdgcn_sched_barrier(0);
    }
#undef KADDR
}
template <int NDB> __device__ __forceinline__ void pv_tile(f32x16 (&o)[NDB], const LAS unsigned char* vb, const f32x16& p0, const f32x16& p1) {
    bf16x8 pa[4];
    { u32x4 w;
      w = (u32x4){cvtpk(p0[0], p0[1]), cvtpk(p0[2], p0[3]), cvtpk(p0[4], p0[5]), cvtpk(p0[6], p0[7])}; pa[0] = __builtin_bit_cast(bf16x8, w);
      w = (u32x4){cvtpk(p0[8], p0[9]), cvtpk(p0[10], p0[11]), cvtpk(p0[12], p0[13]), cvtpk(p0[14], p0[15])}; pa[1] = __builtin_bit_cast(bf16x8, w);
      w = (u32x4){cvtpk(p1[0], p1[1]), cvtpk(p1[2], p1[3]), cvtpk(p1[4], p1[5]), cvtpk(p1[6], p1[7])}; pa[2] = __builtin_bit_cast(bf16x8, w);
      w = (u32x4){cvtpk(p1[8], p1[9]), cvtpk(p1[10], p1[11]), cvtpk(p1[12], p1[13]), cvtpk(p1[14], p1[15])}; pa[3] = __builtin_bit_cast(bf16x8, w); }
    constexpr int N = 4 * NDB, RD = 3;
    s16x4 lo[N], hi[N];
#define VADDR(i) (vb + ((i) % NDB) * 4160 + ((i) / NDB) * 1024)
#pragma unroll
    for (int i = 0; i < RD; ++i) { lo[i] = vtr(VADDR(i)); hi[i] = vtr(VADDR(i) + 512); }
    __builtin_amdgcn_sched_barrier(0);
#pragma unroll
    for (int i = 0; i < N; ++i) {
        if (i + RD < N) { lo[i + RD] = vtr(VADDR(i + RD)); hi[i + RD] = vtr(VADDR(i + RD) + 512); }
        const bf16x8 vf = {lo[i][0], lo[i][1], lo[i][2], lo[i][3], hi[i][0], hi[i][1], hi[i][2], hi[i][3]};
        o[i % NDB] = MFMA32(pa[i / NDB], vf, o[i % NDB]);
        __builtin_amdgcn_sched_barrier(0);
    }
#undef VADDR
}
template <int MODE> __device__ __forceinline__ void row_pass(const LAS float* E, int tid, size_t grow0, int col0, const bf16* G, bf16* O, const float* subg, float post) {
    const int row = tid >> 2, seg = tid & 3; const LAS float* e = E + row * 132 + 32 * seg;
    float v[32];
#pragma unroll
    for (int i = 0; i < 8; ++i) { const f32x4 x = *(const LAS f32x4*)(e + 4 * i); v[4 * i] = x[0]; v[4 * i + 1] = x[1]; v[4 * i + 2] = x[2]; v[4 * i + 3] = x[3]; }
    if (MODE == 1) { float ss = 0.f;
#pragma unroll
        for (int i = 0; i < 32; ++i) ss += v[i] * v[i];
        ss += __shfl_xor(ss, 1); ss += __shfl_xor(ss, 2);
        const float rstd = 1.0f / sqrtf(ss * (1.0f / 128.0f) + EPS);
#pragma unroll
        for (int i = 0; i < 32; ++i) v[i] *= rstd; }
    const size_t off = (grow0 + row) * DM + col0 + 32 * seg;
#pragma unroll
    for (int i = 0; i < 4; ++i) { const u32x4 g = *(const u32x4*)(G + off + 8 * i); u32x4 w;
#pragma unroll
        for (int j = 0; j < 4; ++j) { const float lo = v[8 * i + 2 * j] * __uint_as_float(g[j] << 16), hi = v[8 * i + 2 * j + 1] * __uint_as_float(g[j] & 0xffff0000u); w[j] = cvtpk(lo, hi); }
        *(u32x4*)(O + off + 8 * i) = w; }
}

#define XB_TMO      128
#define XB_XCNT(j)  (256  + 64 * (j))
#define XB_XSUB(j)  (1280 + 64 * (j))
#define XB_XGEN(j)  (2304 + 64 * (j))
#define XB_TOP      3328
#define XB_TOPGEN   3392
#define XCD_BAR_WORDS 3456
#define XB_SPIN_CAP (1u << 18)

__device__ __forceinline__ unsigned xb_ld(unsigned* p)              { return __hip_atomic_load(p, __ATOMIC_RELAXED, __HIP_MEMORY_SCOPE_AGENT); }
__device__ __forceinline__ unsigned xb_add(unsigned* p, unsigned v) { return __hip_atomic_fetch_add(p, v, __ATOMIC_RELAXED, __HIP_MEMORY_SCOPE_AGENT); }
__device__ __forceinline__ unsigned xb_xcc_id() { return (unsigned)__builtin_amdgcn_s_getreg((3 << 11) | 20) & 0xFu; }
#define XB_SPIN(cond, bar) do { unsigned _sp = 0; while (cond) { __builtin_amdgcn_s_sleep(1); \
    if ((++_sp & 255u) == 0u) { if (xb_ld(&(bar)[XB_TMO])) break; if (_sp > XB_SPIN_CAP) { atomicAdd(&(bar)[XB_TMO], 1u); break; } } } } while (0)

struct XcdBarrier {
    unsigned* bar; unsigned x;
    volatile LAS unsigned* st;
};

__device__ __forceinline__ XcdBarrier xcd_barrier_post(unsigned* bar, volatile LAS unsigned* st) {
    XcdBarrier b; b.bar = bar; b.x = xb_xcc_id(); b.st = st;
    if (threadIdx.x == 0) (void)xb_add(&bar[XB_XCNT(b.x)], 1u);
    return b;
}
__device__ __forceinline__ void xcd_barrier_complete(unsigned* bar, unsigned x, unsigned& nloc, unsigned& nx) {
    const unsigned G = gridDim.x * gridDim.y * gridDim.z;
    unsigned sum, cnt, mine, sp = 0u;
    for (;;) {
        sum = 0u; cnt = 0u; mine = 0u;
#pragma unroll
        for (unsigned j = 0; j < 16; ++j) { const unsigned c = xb_ld(&bar[XB_XCNT(j)]); sum += c; cnt += (c > 0u) ? 1u : 0u; mine = (j == x) ? c : mine; }
        if (sum == G) break;
        __builtin_amdgcn_s_sleep(1);
        if ((++sp & 255u) == 0u) { if (xb_ld(&bar[XB_TMO])) break; if (sp > XB_SPIN_CAP) { atomicAdd(&bar[XB_TMO], 1u); break; } }
    }
    nloc = mine > 0u ? mine : 1u; nx = cnt > 0u ? cnt : 1u;
}

__device__ __forceinline__ void xcd_barrier(const XcdBarrier& b) {
    asm volatile("s_waitcnt vmcnt(0)" ::: "memory");
    __syncthreads();
    if (threadIdx.x == 0) {
        unsigned* bar = b.bar;
        __builtin_amdgcn_s_waitcnt(0);
        unsigned nloc = b.st[0], nx = b.st[1];
        if (nloc == 0u) { xcd_barrier_complete(bar, b.x, nloc, nx); b.st[0] = nloc; b.st[1] = nx; }
        const unsigned old = xb_add(&bar[XB_XSUB(b.x)], 1u);
        const unsigned gen = old / nloc;
        if (old + 1u == (gen + 1u) * nloc) {
            __builtin_amdgcn_fence(__ATOMIC_RELEASE, "agent");
            asm volatile("s_waitcnt vmcnt(0)" ::: "memory");
            const unsigned og = xb_add(&bar[XB_TOP], 1u);
            const unsigned tg = og / nx;
            if (og + 1u == (tg + 1u) * nx) xb_add(&bar[XB_TOPGEN], 1u);
            else XB_SPIN(xb_ld(&bar[XB_TOPGEN]) == tg, bar);
            __builtin_amdgcn_fence(__ATOMIC_ACQUIRE, "agent");
            xb_add(&bar[XB_XGEN(b.x)], 1u);
            asm volatile("s_waitcnt vmcnt(0)" ::: "memory");
        } else {
            XB_SPIN(xb_ld(&bar[XB_XGEN(b.x)]) == gen, bar);
            __builtin_amdgcn_fence(__ATOMIC_ACQUIRE, "agent");
            asm volatile("s_waitcnt vmcnt(0)" ::: "memory");
        }
    }
    __syncthreads();
}

__device__ __forceinline__ void stick_attn_phase(LAS unsigned char* lds, int vcu, int G, const bf16* Qt, const bf16* Kt, const bf16* Vt, const bf16* Gt, bf16* Ot) {
    int tid_ = threadIdx.x; asm volatile("" : "+v"(tid_)); const int tid = tid_, lane = tid & 63, w = __builtin_amdgcn_readfirstlane(tid >> 6), r32 = lane & 31, hi = lane >> 5;
    const int c = w >> 2, jw = w & 3;
    const KVMap map = kv_map(w, lane);
    const LAS unsigned char* kfb = lds + c * 8448 + hi * 1056 + r32 * 16;
    const LAS unsigned char* vfb = lds + 17408 + (2 * c) * 4160 + (4 * hi + ((lane & 15) >> 2)) * 64 + ((lane >> 4) & 1) * 32 + (lane & 3) * 8;
    LAS float* E = (LAS float*)lds;
    volatile LAS float* flags = (volatile LAS float*)(lds + ATT_FLAGS);
    for (int u = vcu; u < 1024; u += G) {
        const int bhp = u >> 6, qb = u & 63, b = bhp >> 3, hp = bhp & 7;
        const size_t rowbase = (size_t)b * SEQ; const int q0 = qb * 128, q0w = q0 + 32 * jw, qrow = q0w + r32, col0 = hp * 128;
        const int tmax = 2 * qb + 1, tw = (q0w + 30) >> 6;
        bf16x8 qr[4];
#pragma unroll
        for (int d0 = 0; d0 < 4; ++d0) qr[d0] = *(const bf16x8*)(Qt + (rowbase + qrow) * DM + col0 + c * 64 + d0 * 16 + hi * 8);
        f32x16 o[2];
#pragma unroll
        for (int r = 0; r < 16; ++r) { o[0][r] = 0.f; o[1][r] = 0.f; }
        float crun = 1.0f; bool active = true;
        KVStage st;
        kv_gload(st, Kt + (rowbase + 64 * tmax) * DM + col0, Vt + (rowbase + 64 * tmax) * DM + col0, map);
        kv_lstore(st, lds, map);
        __builtin_amdgcn_s_waitcnt(0);
        __syncthreads();
        int it = 0;
        for (int t = tmax; t >= 0; --t, ++it) {
            const int cur = it & 1;
            if (t > 0) kv_gload(st, Kt + (rowbase + 64 * (t - 1)) * DM + col0, Vt + (rowbase + 64 * (t - 1)) * DM + col0, map);
            if (active && t <= tw) {
                f32x16 p0, p1, l0, l1;
                qk_tile(p0, p1, kfb + cur * 34048, qr, 0.f);
                const bool need_mask = (64 * t + 63 >= q0w);
                const int kv0 = 64 * t;
#pragma unroll
                for (int r = 0; r < 16; ++r) {
                    { const float z = p0[r], e = __builtin_amdgcn_exp2f(-fabsf(z)), rr = __builtin_amdgcn_rcpf(1.0f + e), er = e * rr; float nb = (z >= 0.f) ? er : rr, bb = (z >= 0.f) ? rr : er;
                      if (need_mask && (kv0 + crow(r, hi) >= qrow)) { nb = 1.f; bb = 0.f; } l0[r] = nb; p0[r] = bb; }
                    { const float z = p1[r], e = __builtin_amdgcn_exp2f(-fabsf(z)), rr = __builtin_amdgcn_rcpf(1.0f + e), er = e * rr; float nb = (z >= 0.f) ? er : rr, bb = (z >= 0.f) ? rr : er;
                      if (need_mask && (kv0 + 32 + crow(r, hi) >= qrow)) { nb = 1.f; bb = 0.f; } l1[r] = nb; p1[r] = bb; }
                }
                float S[16];
#pragma unroll
                for (int g = 0; g < 4; ++g) {
                    const float s0 = (l0[4 * g] * l0[4 * g + 1]) * (l0[4 * g + 2] * l0[4 * g + 3]);
                    const float s1 = (l1[4 * g] * l1[4 * g + 1]) * (l1[4 * g + 2] * l1[4 * g + 3]);
                    auto ra = __builtin_amdgcn_permlane32_swap(__float_as_uint(s0), __float_as_uint(s0), false, false);
                    auto rb = __builtin_amdgcn_permlane32_swap(__float_as_uint(s1), __float_as_uint(s1), false, false);
                    S[2 * g] = __uint_as_float(ra[0]); S[2 * g + 1] = __uint_as_float(ra[1]); S[8 + 2 * g] = __uint_as_float(rb[0]); S[8 + 2 * g + 1] = __uint_as_float(rb[1]);
                }
                float suf[16]; suf[15] = crun;
#pragma unroll
                for (int g = 14; g >= 0; --g) suf[g] = suf[g + 1] * S[g + 1];
                crun = suf[0] * S[0];
#pragma unroll
                for (int g = 0; g < 4; ++g) {
                    { const float e3 = hi ? suf[2 * g + 1] : suf[2 * g], e2 = e3 * l0[4 * g + 3], e1 = e2 * l0[4 * g + 2], e0 = e1 * l0[4 * g + 1];
                      p0[4 * g] *= e0; p0[4 * g + 1] *= e1; p0[4 * g + 2] *= e2; p0[4 * g + 3] *= e3; }
                    { const float e3 = hi ? suf[8 + 2 * g + 1] : suf[8 + 2 * g], e2 = e3 * l1[4 * g + 3], e1 = e2 * l1[4 * g + 2], e0 = e1 * l1[4 * g + 1];
                      p1[4 * g] *= e0; p1[4 * g + 1] *= e1; p1[4 * g + 2] *= e2; p1[4 * g + 3] *= e3; }
                }
                pv_tile<2>(o, vfb + cur * 34048, p0, p1);
                float mx = crun;
#pragma unroll
                for (int off = 1; off < 32; off <<= 1) mx = fmaxf(mx, __shfl_xor(mx, off));
                if (mx <= SB_MASS) active = false;
            }
            if (lane == 0) flags[cur * 8 + w] = active ? 0.f : 1.f;
            if (t > 0) kv_lstore(st, lds + (cur ^ 1) * 34048, map);
            __syncthreads();
            float fs = 0.f;
#pragma unroll
            for (int i = 0; i < 8; ++i) fs += flags[cur * 8 + i];
            if (fs >= 7.5f) break;
        }
#pragma unroll
        for (int db = 0; db < 2; ++db)
#pragma unroll
            for (int r = 0; r < 16; ++r) E[(32 * jw + crow(r, hi)) * 132 + 64 * c + 32 * db + r32] = o[db][r];
        __syncthreads();
        row_pass<0>(E, tid, rowbase + q0, col0, Gt, Ot, nullptr, 1.f);
        __syncthreads();
    }
}

#define DSB() __builtin_amdgcn_sched_barrier(0)
#define EXP4_ASM(P, R, S0, S1) asm volatile("v_exp_f32_e32 %0, %0\n\tv_exp_f32_e32 %1, %1\n\tv_exp_f32_e32 %2, %2\n\tv_exp_f32_e32 %3, %3\n\t" \
    "v_add_f32_e32 %4, %4, %0\n\tv_add_f32_e32 %5, %5, %1\n\tv_add_f32_e32 %4, %4, %2\n\tv_add_f32_e32 %5, %5, %3" \
    : "+v"(P[R]), "+v"(P[R + 1]), "+v"(P[R + 2]), "+v"(P[R + 3]), "+v"(S0), "+v"(S1))
#define EXP4_FIRST(P, S0, S1) do { P[0] = __builtin_amdgcn_exp2f(P[0]); P[1] = __builtin_amdgcn_exp2f(P[1]); P[2] = __builtin_amdgcn_exp2f(P[2]); P[3] = __builtin_amdgcn_exp2f(P[3]); \
    S0 = P[0] + P[2]; S1 = P[1] + P[3]; } while (0)
__device__ __forceinline__ void diff_tile(f32x16 (&o)[4], float& lsum, const LAS unsigned char* kb, const LAS unsigned char* vb, const bf16x8 (&qr)[4], float negm, bool need_mask, int lim) {
    f32x16 p0, p1;
#pragma unroll
    for (int r = 0; r < 16; ++r) { p0[r] = negm; p1[r] = negm; }
    bf16x8 kf[8];
#define KADDR(i) (kb + ((i) & 3) * 2112 + ((i) >> 2) * 512)
#define VADDR(i) (vb + ((i) & 3) * 4160 + ((i) >> 2) * 1024)
    kf[0] = *(const LAS bf16x8*)KADDR(0); kf[1] = *(const LAS bf16x8*)KADDR(1); kf[2] = *(const LAS bf16x8*)KADDR(2);
    DSB();
#pragma unroll
    for (int i = 0; i < 4; ++i) { kf[i + 3] = *(const LAS bf16x8*)KADDR(i + 3); p0 = MFMA32(kf[i], qr[i], p0); DSB(); }
    float s0, s1, s2, s3;
    s16x4 lo[16], hh[16];
    kf[7] = *(const LAS bf16x8*)KADDR(7); p1 = MFMA32(kf[4], qr[0], p1);
    if (need_mask) {
#pragma unroll
        for (int r = 0; r < 16; ++r) if ((r & 3) + 8 * (r >> 2) > lim) p0[r] = -INFINITY; }
    EXP4_FIRST(p0, s0, s1); DSB();
    p1 = MFMA32(kf[5], qr[1], p1); EXP4_ASM(p0, 4, s0, s1); DSB();
    p1 = MFMA32(kf[6], qr[2], p1); EXP4_ASM(p0, 8, s0, s1); lo[0] = vtr(VADDR(0)); hh[0] = vtr(VADDR(0) + 512); DSB();
    p1 = MFMA32(kf[7], qr[3], p1); EXP4_ASM(p0, 12, s0, s1); lo[1] = vtr(VADDR(1)); hh[1] = vtr(VADDR(1) + 512); DSB();
    bf16x8 pa[4];
    { u32x4 w;
      w = (u32x4){cvtpk(p0[0], p0[1]), cvtpk(p0[2], p0[3]), cvtpk(p0[4], p0[5]), cvtpk(p0[6], p0[7])}; pa[0] = __builtin_bit_cast(bf16x8, w);
      w = (u32x4){cvtpk(p0[8], p0[9]), cvtpk(p0[10], p0[11]), cvtpk(p0[12], p0[13]), cvtpk(p0[14], p0[15])}; pa[1] = __builtin_bit_cast(bf16x8, w); }
    lo[2] = vtr(VADDR(2)); hh[2] = vtr(VADDR(2) + 512);
    DSB();
#define PVSTEP(i) do { if ((i) + 3 < 16) { lo[(i) + 3] = vtr(VADDR((i) + 3)); hh[(i) + 3] = vtr(VADDR((i) + 3) + 512); } \
        { const bf16x8 vf_ = {lo[i][0], lo[i][1], lo[i][2], lo[i][3], hh[i][0], hh[i][1], hh[i][2], hh[i][3]}; o[(i) & 3] = MFMA32(pa[(i) >> 2], vf_, o[(i) & 3]); } } while (0)
    PVSTEP(0);
    if (need_mask) {
#pragma unroll
        for (int r = 0; r < 16; ++r) if (32 + (r & 3) + 8 * (r >> 2) > lim) p1[r] = -INFINITY; }
    EXP4_FIRST(p1, s2, s3); DSB();
    PVSTEP(1); DSB();
    PVSTEP(2); EXP4_ASM(p1, 4, s2, s3); DSB();
    PVSTEP(3); DSB();
    PVSTEP(4); EXP4_ASM(p1, 8, s2, s3); DSB();
    PVSTEP(5); DSB();
    PVSTEP(6); EXP4_ASM(p1, 12, s2, s3); DSB();
    PVSTEP(7);
    { u32x4 w;
      w = (u32x4){cvtpk(p1[0], p1[1]), cvtpk(p1[2], p1[3]), cvtpk(p1[4], p1[5]), cvtpk(p1[6], p1[7])}; pa[2] = __builtin_bit_cast(bf16x8, w);
      w = (u32x4){cvtpk(p1[8], p1[9]), cvtpk(p1[10], p1[11]), cvtpk(p1[12], p1[13]), cvtpk(p1[14], p1[15])}; pa[3] = __builtin_bit_cast(bf16x8, w); }
    DSB();
#pragma unroll
    for (int i = 8; i < 16; ++i) { PVSTEP(i); DSB(); }
    lsum += (s0 + s1) + (s2 + s3);
#undef PVSTEP
#undef KADDR
#undef VADDR
}
__device__ __forceinline__ void diff_attn_phase(LAS unsigned char* lds, int vcu, int G, const bf16* Qt, const bf16* Kt, const bf16* Vt, const bf16* Gt, bf16* Ot,
                                                const float* qg, const float* kg, const float* lamp, const float* subg) {
    int tid_ = threadIdx.x; asm volatile("" : "+v"(tid_)); const int tid = tid_, lane = tid & 63, w = __builtin_amdgcn_readfirstlane(tid >> 6), r32 = lane & 31, hi = lane >> 5;
    const int c = w >> 2, jw = w & 3;
    float lam, post, negm;
    { float a = lamp[lane] * lamp[64 + lane], bb = lamp[128 + lane] * lamp[192 + lane]; a = wave_sum(a); bb = wave_sum(bb);
      const float lam_init = 0.8f - 0.6f * expf(-0.3f); lam = expf(a) - expf(bb) + lam_init; post = 1.0f - lam_init;
      const float gq = wave_max(fabsf(qg[lane])), gk = wave_max(fabsf(kg[lane])); negm = -(8.0f * gq * gk * LOG2E); }
    const KVMap map = kv_map(w, lane);
    const LAS unsigned char* kfb = lds + c * 8448 + hi * 1056 + r32 * 16;
    const LAS unsigned char* vfb = lds + 17408 + (4 * hi + ((lane & 15) >> 2)) * 64 + ((lane >> 4) & 1) * 32 + (lane & 3) * 8;
    LAS float* E = (LAS float*)lds;
    LAS float* wsf = (LAS float*)(lds + DIFF_WSF) + w * 64;
    for (int pi = vcu; pi < 512; pi += G) {
        const int bh = pi >> 5, jj = pi & 31, b = bh >> 3, h = bh & 7;
        const size_t rowbase = (size_t)b * SEQ; const int col0 = h * 128;
        for (int uu = 0; uu < 2; ++uu) {
            const int qb = uu ? 63 - jj : jj, q0 = qb * 128, q0w = q0 + 32 * jw, qrow = q0w + r32, NTL = 2 * qb + 2;
            bf16x8 qr[4];
#pragma unroll
            for (int d0 = 0; d0 < 4; ++d0) qr[d0] = *(const bf16x8*)(Qt + (rowbase + qrow) * DM + col0 + c * 64 + d0 * 16 + hi * 8);
            f32x16 o[4];
#pragma unroll
            for (int r = 0; r < 16; ++r) { o[0][r] = 0.f; o[1][r] = 0.f; o[2][r] = 0.f; o[3][r] = 0.f; }
            float lsum = 0.f;
            KVStage st;
            kv_gload(st, Kt + rowbase * DM + col0, Vt + rowbase * DM + col0, map);
            kv_lstore(st, lds, map);
            kv_gload(st, Kt + (rowbase + 64) * DM + col0, Vt + (rowbase + 64) * DM + col0, map);
            kv_lstore(st, lds + 34048, map);
            __builtin_amdgcn_s_waitcnt(0);
            __syncthreads();
            const int NS = NTL >> 1;
            for (int u = 0; u < NS; ++u) {
                const int cb = (u & 1) * 68096, nb = cb ^ 68096; const bool more = (u + 1 < NS);
                if (more) kv_gload(st, Kt + (rowbase + 64 * (2 * u + 2)) * DM + col0, Vt + (rowbase + 64 * (2 * u + 2)) * DM + col0, map);
#pragma unroll
                for (int j = 0; j < 2; ++j) {
                    const int t = 2 * u + j;
                    if (64 * t <= q0w + 31) { int lim = qrow - 64 * t - 4 * hi; asm volatile("" : "+v"(lim));
                        diff_tile(o, lsum, kfb + cb + j * 34048, vfb + cb + j * 34048, qr, negm, 64 * t + 63 > q0w, lim); }
                    if (more) { kv_lstore(st, lds + nb + j * 34048, map);
                        if (j == 0) kv_gload(st, Kt + (rowbase + 64 * (2 * u + 3)) * DM + col0, Vt + (rowbase + 64 * (2 * u + 3)) * DM + col0, map); }
                }
                __syncthreads();
            }
            { auto rr = __builtin_amdgcn_permlane32_swap(__float_as_uint(lsum), __float_as_uint(lsum), false, false); lsum = __uint_as_float(rr[0]) + __uint_as_float(rr[1]); }
            if (hi == 0) wsf[r32] = (c ? lam : 1.0f) / lsum;
            float rli[16];
#pragma unroll
            for (int r = 0; r < 16; ++r) rli[r] = wsf[crow(r, hi)];
            if (c == 1) {
#pragma unroll
                for (int db = 0; db < 4; ++db)
#pragma unroll
                    for (int r = 0; r < 16; ++r) E[(32 * jw + crow(r, hi)) * 132 + 32 * db + r32] = o[db][r] * rli[r];
            }
            __syncthreads();
            if (c == 0) {
#pragma unroll
                for (int db = 0; db < 4; ++db)
#pragma unroll
                    for (int r = 0; r < 16; ++r) { LAS float* e = E + (32 * jw + crow(r, hi)) * 132 + 32 * db + r32; *e = o[db][r] * rli[r] - *e; }
            }
            __syncthreads();
            row_pass<1>(E, tid, rowbase + q0, col0, Gt, Ot, subg, post);
            __syncthreads();
        }
    }
}

__device__ __forceinline__ unsigned f2bf(float f) { unsigned u = __builtin_bit_cast(unsigned, f); return (u + 0x7fffu + ((u >> 16) & 1u)) >> 16; }
__device__ __forceinline__ unsigned pk2(float lo, float hi) { return f2bf(lo) | (f2bf(hi) << 16); }
__device__ __forceinline__ void p0_transpose_item(const float* W, const float* g, int K, int N, bf16* WT, int row_off, LAS float* scr, int item, int lane, int perm_below = 0) {
    const int nblk = N / 32, kb = item / nblk, nb = item % nblk, k0 = 64 * kb, n0 = 32 * nb;
    const int np0 = (n0 < perm_below) ? ((n0 & ~255) + 128 * ((n0 >> 5) & 1) + 32 * ((n0 & 255) >> 6)) : n0;
    float wv[32];
#pragma unroll
    for (int i = 0; i < 32; ++i) { const int kk = 2 * i + (lane >> 5); wv[i] = W[(size_t)(k0 + kk) * N + n0 + (lane & 31)]; }
#pragma unroll
    for (int i = 0; i < 32; ++i) { const int kk = 2 * i + (lane >> 5); scr[kk * 33 + (lane & 31)] = wv[i]; }
    asm volatile("s_waitcnt lgkmcnt(0)" ::: "memory");
    const int cc = lane & 7;
    f32x4 ga = {1.f, 1.f, 1.f, 1.f}, gb = ga;
    if (g) { ga = *(const f32x4*)(g + k0 + 8 * cc); gb = *(const f32x4*)(g + k0 + 8 * cc + 4); }
#pragma unroll
    for (int j = 0; j < 4; ++j) { const int n = (lane >> 3) + 8 * j; const LAS float* s = scr + (8 * cc) * 33 + n;
        u32x4 o; o.x = pk2(s[0 * 33] * ga[0], s[1 * 33] * ga[1]); o.y = pk2(s[2 * 33] * ga[2], s[3 * 33] * ga[3]); o.z = pk2(s[4 * 33] * gb[0], s[5 * 33] * gb[1]); o.w = pk2(s[6 * 33] * gb[2], s[7 * 33] * gb[3]);
        *(u32x4*)(WT + (size_t)(row_off + np0 + n) * K + k0 + 8 * cc) = o; }
    asm volatile("s_waitcnt lgkmcnt(0)" ::: "memory");
}
__device__ __forceinline__ void rms_row_to_bf16(const float* xrow, bf16* orow, int lane) {
    const f32x4* xr = (const f32x4*)xrow + lane;
    f32x4 v[4]; float s = 0.f;
#pragma unroll
    for (int j = 0; j < 4; ++j) { v[j] = xr[64 * j]; s += (v[j].x * v[j].x + v[j].y * v[j].y) + (v[j].z * v[j].z + v[j].w * v[j].w); }
    const float rstd = 1.0f / sqrtf(wave_sum(s) * (1.0f / DM) + EPS);
    unsigned long long* o8 = (unsigned long long*)orow + lane;
#pragma unroll
    for (int j = 0; j < 4; ++j) o8[64 * j] = (unsigned long long)pk2(v[j].x * rstd, v[j].y * rstd) | ((unsigned long long)pk2(v[j].z * rstd, v[j].w * rstd) << 32);
}
__device__ __forceinline__ void qk_norm_rope_item(bf16* Kraw, bf16* Qraw, const float* kg, const float* qg, const f32x2* rope, int idx) {
    const int row = idx >> 5, c32 = idx & 31; const bool isq = c32 >= 16;
    bf16* p = (isq ? Qraw : Kraw) + (size_t)row * DM + (c32 & 15) * 64; const float* g = isq ? qg : kg;
    u32x4 raw[8];
#pragma unroll
    for (int i = 0; i < 8; ++i) raw[i] = *(const u32x4*)(p + 8 * i);
    float v[64]; float ss = 0.f;
#pragma unroll
    for (int i = 0; i < 8; ++i)
#pragma unroll
        for (int j = 0; j < 4; ++j) { const float lo = __uint_as_float(raw[i][j] << 16), hi = __uint_as_float(raw[i][j] & 0xffff0000u); v[8 * i + 2 * j] = lo; v[8 * i + 2 * j + 1] = hi; ss += lo * lo + hi * hi; }
    const float rstd = (isq ? QS : 1.0f) / sqrtf(ss * (1.0f / 64.0f) + EPS);
    const f32x2* cs = rope + (size_t)row * 32;
#pragma unroll
    for (int i = 0; i < 32; ++i) { const f32x2 t = cs[i]; const float t1 = v[i] * rstd * g[i], t2 = v[i + 32] * rstd * g[i + 32]; v[i] = t1 * t.x - t2 * t.y; v[i + 32] = t2 * t.x + t1 * t.y; }
#pragma unroll
    for (int i = 0; i < 8; ++i) { u32x4 o;
#pragma unroll
        for (int j = 0; j < 4; ++j) o[j] = cvtpk(v[8 * i + 2 * j], v[8 * i + 2 * j + 1]);
        *(u32x4*)(p + 8 * i) = o; }
}

struct Args { const float* x; const int* pos; const float* a_norm_g; const float* a_w_in; const float* a_w_out; const float* kv_norm_g; const float* w_kv; const float* k_norm_g;
              const float* b_norm_g; const float* b_w_in; const float* b_q_norm_g; const float* b_lambda; const float* b_subln_g; const float* b_w_out; float* out; unsigned char* ws; int cg_seams; int pad_; };

__global__ void __launch_bounds__(NTHR, 2) yoco_fwd(Args a) {
    extern __shared__ __attribute__((aligned(16))) unsigned char lds_raw[];
    LAS unsigned char* lds = (LAS unsigned char*)lds_raw;
    cg::grid_group grid = cg::this_grid();
    const int tid = threadIdx.x, lane = tid & 63, wave = __builtin_amdgcn_readfirstlane(tid >> 6);
    const int G = gridDim.x, bx = blockIdx.x, vcu = (G % 8 == 0) ? (bx % 8) * (G / 8) + bx / 8 : bx;
    unsigned char* ws = a.ws;
    if (tid < 16) ((LAS unsigned*)(lds + LDS_CTL))[tid] = 0u;
    __syncthreads();
    const XcdBarrier bar = xcd_barrier_post((unsigned*)(ws + WS_BAR), (volatile LAS unsigned*)(lds + LDS_CTL));
    float* sumsq = (float*)(ws + WS_SUMSQ); unsigned* rope = (unsigned*)(ws + WS_ROPE);
    bf16* WinA = (bf16*)(ws + WS_WINA); bf16* WoutA = (bf16*)(ws + WS_WOUTA); bf16* WB = (bf16*)(ws + WS_WB); bf16* WoutB = (bf16*)(ws + WS_WOUTB);
    bf16* XA = (bf16*)(ws + WS_XA); bf16* T0 = (bf16*)(ws + WS_T); bf16* T1 = T0 + TSTRIDE; bf16* T2 = T1 + TSTRIDE; bf16* T3 = T2 + TSTRIDE; bf16* OB = (bf16*)(ws + WS_O);

    {
        LAS float* scr = (LAS float*)(lds + wave * 16384);
        const int gw = vcu * NWAVES + wave, NGW = G * NWAVES;
        constexpr int I_INA = 16 * 128, I_OUT = 16 * 32, I_KV = 16 * 64, I_BIN = 16 * 64;
        constexpr int NITEMS = I_INA + I_OUT + I_KV + I_BIN + I_OUT;
        for (int it = gw; it < NITEMS; it += NGW) {
            int r = it;
            if (r < I_INA) { p0_transpose_item(a.a_w_in, a.a_norm_g, DM, 4096, WinA, 0, scr, r, lane); continue; } r -= I_INA;
            if (r < I_OUT) { p0_transpose_item(a.a_w_out, nullptr, DM, DM, WoutA, 0, scr, r, lane); continue; } r -= I_OUT;
            if (r < I_KV) { p0_transpose_item(a.w_kv, a.kv_norm_g, DM, 2048, WB, 0, scr, r, lane, 1024); continue; } r -= I_KV;
            if (r < I_BIN) { p0_transpose_item(a.b_w_in, a.b_norm_g, DM, 2048, WB, 2048, scr, r, lane, 1024); continue; } r -= I_BIN;
            p0_transpose_item(a.b_w_out, nullptr, DM, DM, WoutB, 0, scr, r, lane);
        }
        for (int m = gw; m < M; m += 2 * NGW) {
            const f32x4* xa0 = (const f32x4*)(a.x + (size_t)m * DM) + lane; const int m1 = (m + NGW < M) ? m + NGW : m; const f32x4* xa1 = (const f32x4*)(a.x + (size_t)m1 * DM) + lane;
            f32x4 v0[4], v1[4]; float q0 = 0.f, q1 = 0.f;
#pragma unroll
            for (int j = 0; j < 4; ++j) { v0[j] = xa0[64 * j]; v1[j] = xa1[64 * j]; }
#pragma unroll
            for (int j = 0; j < 4; ++j) { q0 += (v0[j].x * v0[j].x + v0[j].y * v0[j].y) + (v0[j].z * v0[j].z + v0[j].w * v0[j].w); q1 += (v1[j].x * v1[j].x + v1[j].y * v1[j].y) + (v1[j].z * v1[j].z + v1[j].w * v1[j].w); }
            const float r0 = 1.0f / sqrtf(wave_sum(q0) * (1.0f / DM) + EPS), r1 = 1.0f / sqrtf(wave_sum(q1) * (1.0f / DM) + EPS);
            unsigned long long* o0 = (unsigned long long*)(XA + (size_t)m * DM) + lane; unsigned long long* o1 = (unsigned long long*)(XA + (size_t)m1 * DM) + lane;
#pragma unroll
            for (int j = 0; j < 4; ++j) { o0[64 * j] = (unsigned long long)pk2(v0[j].x * r0, v0[j].y * r0) | ((unsigned long long)pk2(v0[j].z * r0, v0[j].w * r0) << 32);
                o1[64 * j] = (unsigned long long)pk2(v1[j].x * r1, v1[j].y * r1) | ((unsigned long long)pk2(v1[j].z * r1, v1[j].w * r1) << 32); }
        }
        const int gt = vcu * NTHR + tid, NGT = G * NTHR;
        for (int idx = gt; idx < M * 32; idx += NGT) {
            const int row = idx >> 5, i = idx & 31;
            const float inv = (float)exp2(-(double)i * (13.287712379549449 / 32.0));
            const float ang = (float)a.pos[row] * inv;
            const double ad = (double)ang; const double kq = rint(ad * 0.15915494309189535);
            double rr = fma(-kq, 6.283185307179586, ad); rr = fma(-kq, 2.4492935982947064e-16, rr);
            const float rf = (float)rr;
            rope[idx] = pk2(cosf(rf), sinf(rf));
        }
    }
    if (a.cg_seams) grid.sync(); else xcd_barrier(bar);
    { pg8::Gemm g{XA, WinA, M, 4096, DM}; pg8::StaticOrder S; S.init(M, 4096, G, bx);
      pg8::EpiSplit4 E{T0, TSTRIDE, nullptr, QS, 0, 3};
      pg8::gemm_phase<pg8::EpiSplit4, pg8::StaticOrder, true, true>(lds, g, S, E); }
    if (a.cg_seams) grid.sync(); else xcd_barrier(bar);
    stick_attn_phase(lds, vcu, G, T0, T1, T2, T3, OB);
    if (a.cg_seams) grid.sync(); else xcd_barrier(bar);
    { pg8::Gemm g{OB, WoutA, M, DM, DM}; pg8::StaticOrder S; S.init(M, DM, G, bx);
      pg8::EpiRes E{a.x, nullptr, XA, sumsq};
      pg8::gemm_phase<pg8::EpiRes, pg8::StaticOrder, true, true>(lds, g, S, E); }
    if (a.cg_seams) grid.sync(); else xcd_barrier(bar);
    { pg8::Gemm g{XA, WB, M, 4096, DM}; pg8::StaticOrder S; S.init(M, 4096, G, bx);
      pg8::EpiB E{T0, TSTRIDE, sumsq, a.k_norm_g, a.b_q_norm_g, (const unsigned*)rope, QS, a.b_subln_g, 1.0f - (0.8f - 0.6f * expf(-0.3f))};
      pg8::gemm_phase<pg8::EpiB, pg8::StaticOrder, true, true>(lds, g, S, E); }
    if (a.cg_seams) grid.sync(); else xcd_barrier(bar);
    diff_attn_phase(lds, vcu, G, T2, T0, T1, T3, OB, a.b_q_norm_g, a.k_norm_g, a.b_lambda, a.b_subln_g);
    if (a.cg_seams) grid.sync(); else xcd_barrier(bar);
    { pg8::Gemm g{OB, WoutB, M, DM, DM}; pg8::StaticOrder S; S.init(M, DM, G, bx);
      pg8::EpiResBf E{XA, a.out};
      pg8::gemm_phase<pg8::EpiResBf, pg8::StaticOrder, true, true>(lds, g, S, E); }
}
}

extern "C" void kernel_launch(void* const* d_in, const int* in_sizes, int n_in, void* d_out, int out_size, void* d_ws, size_t ws_size, hipStream_t stream) {
    static int grid = 0;
    if (grid == 0) {
        if (n_in != 14 || in_sizes[0] != mk::M * mk::DM || out_size != mk::M * mk::DM || ws_size < mk::WS_END) { fprintf(stderr, "kernel_launch: unexpected shapes (n_in %d, ws %zu); nothing launched\n", n_in, ws_size); grid = -1; return; }
        int dev = 0, cus = 0, per_cu = 0;
        if (hipGetDevice(&dev) != hipSuccess || hipDeviceGetAttribute(&cus, hipDeviceAttributeMultiprocessorCount, dev) != hipSuccess) { grid = -1; return; }
        if (hipFuncSetAttribute((const void*)mk::yoco_fwd, hipFuncAttributeMaxDynamicSharedMemorySize, mk::LDS_BYTES) != hipSuccess) { fprintf(stderr, "kernel_launch: hipFuncSetAttribute failed\n"); grid = -1; return; }
        if (hipOccupancyMaxActiveBlocksPerMultiprocessor(&per_cu, (const void*)mk::yoco_fwd, mk::NTHR, mk::LDS_BYTES) != hipSuccess || per_cu < 1) { fprintf(stderr, "kernel_launch: occupancy query gave %d\n", per_cu); (void)hipGetLastError(); per_cu = 1; }
        grid = cus * per_cu;
    }
    if (grid < 0) return;
    (void)hipMemsetAsync((char*)d_ws, 0, 512 * 1024, stream);
    mk::Args a{};
    a.x = (const float*)d_in[0]; a.pos = (const int*)d_in[1]; a.a_norm_g = (const float*)d_in[2]; a.a_w_in = (const float*)d_in[3]; a.a_w_out = (const float*)d_in[4];
    a.kv_norm_g = (const float*)d_in[5]; a.w_kv = (const float*)d_in[6]; a.k_norm_g = (const float*)d_in[7]; a.b_norm_g = (const float*)d_in[8]; a.b_w_in = (const float*)d_in[9];
    a.b_q_norm_g = (const float*)d_in[10]; a.b_lambda = (const float*)d_in[11]; a.b_subln_g = (const float*)d_in[12]; a.b_w_out = (const float*)d_in[13];
    a.out = (float*)d_out; a.ws = (unsigned char*)d_ws;
    void* args[] = {&a};
    const hipError_t e = hipLaunchCooperativeKernel((const void*)mk::yoco_fwd, dim3(grid), dim3(mk::NTHR), args, mk::LDS_BYTES, stream);
    if (e != hipSuccess) fprintf(stderr, "kernel_launch: cooperative launch failed: %s (grid %d)\n", hipGetErrorString(e), grid);
}
```

```cpp
#include <hip/hip_runtime.h>
#include <hip/hip_cooperative_groups.h>
#include <cstdio>
#include <cstdint>
#include <cmath>
namespace cg = cooperative_groups;
namespace pg8 {
#define PG8_LAS __attribute__((address_space(3)))
typedef unsigned short bf16_t;
typedef short bf16x8 __attribute__((ext_vector_type(8)));
typedef float f32x4 __attribute__((ext_vector_type(4)));
typedef unsigned u32x4 __attribute__((ext_vector_type(4)));
constexpr int BM = 256, BK = 64, HALF = 128, HTB = HALF * BK * 2  , STAGE_BYTES = 8 * HTB, NXCD = 8, WGM = 8;

__host__ __device__ __forceinline__ int lds_byte(int r, int c) { const int st = (r >> 4) * 2 + (c >> 5), rr = r & 15, cc = c & 31, ob = rr * 64 + cc * 2; return st * 1024 + (ob ^ (((ob >> 9) & 1) << 5)); }
__host__ __device__ __forceinline__ void stage_rc(int b, int& R, int& C) { const int st = b / 1024, sb = b % 1024, swz = sb ^ (((sb >> 9) & 1) << 5); R = (st >> 1) * 16 + swz / 64; C = (st & 1) * 32 + (swz % 64) / 2; }
__host__ __device__ __forceinline__ int perm32(int rho) { const int n = rho >> 4, i = rho & 15; return 8 * (i >> 2) + 4 * n + (i & 3); }

struct Unit { int pm, pn; };
struct Gemm { const bf16_t* A; const bf16_t* Bt; int M, N, K; };

struct StaticOrder {
    int nM, nN, nwg, G, c;
    __host__ __device__ void init(int M, int N, int G_, int c_) { nM = M / BM; nN = N / BM; nwg = nM * nN; G = G_; c = c_; }
    __host__ __device__ bool next(int i, Unit& u) const {
        const long L = (long)i * G + c; if (L >= nwg) return false;
        int wgid = (int)L; { const int q = nwg / NXCD, r = nwg % NXCD, xcd = wgid % NXCD, off = wgid / NXCD; wgid = (xcd < r ? xcd * (q + 1) : r * (q + 1) + (xcd - r) * q) + off; }
        const int nig = WGM * nN, gid = wgid / nig, fm = gid * WGM, gsz = (nM - fm) < WGM ? (nM - fm) : WGM;
        u.pm = fm + ((wgid % nig) % gsz); u.pn = (wgid % nig) / gsz; return true;
    }
    __device__ __forceinline__ void a_ready(const Unit&) const {}
    __device__ __forceinline__ void done(const Unit&) const {}
};

__device__ __forceinline__ unsigned cvt_pk_bf16(float lo, float hi) { unsigned r; asm volatile("v_cvt_pk_bf16_f32 %0, %1, %2" : "=v"(r) : "v"(lo), "v"(hi)); return r; }
typedef float f32x2 __attribute__((ext_vector_type(2)));
__device__ __forceinline__ f32x2 gelu_pk(f32x2 v) {
    const f32x2 av = __builtin_elementwise_abs(v), d = av * 0.2316418882f + 1.0f;
    f32x2 t; t.x = __builtin_amdgcn_rcpf(d.x); t.y = __builtin_amdgcn_rcpf(d.y);
    f32x2 q = t * 0.5307027145f + (-0.7265760135f); q = q * t + 0.7107068705f; q = q * t + (-0.142248368f); q = q * t + 0.127414796f; q = q * t;
    const f32x2 s = (v * v) * (-0.72134752044f);
    f32x2 e; e.x = __builtin_amdgcn_exp2f(s.x); e.y = __builtin_amdgcn_exp2f(s.y);
    const f32x2 m = v * (q * e), r = v - m;
    f32x2 o; o.x = v.x < 0.f ? m.x : r.x; o.y = v.y < 0.f ? m.y : r.y; return o;
}

template <int ACT  > struct EpiBf16 {
    static constexpr bool PERM = true, AFTER_DRAIN = false; static_assert(ACT == 0 || ACT == 1, "EpiBf16: ACT is 0 (none) or 1 (gelu_pk)");
    bf16_t* O; int ldc; const float* bias; int split_cols; size_t split_stride; float scale0;
    __device__ __forceinline__ void operator()(const f32x4 (&acc)[2][2][4][2], const Unit& u, int wr, int wc, int fr, int fq) const {
        const int row0 = u.pm * BM + wr * 64 + fr; int colt = u.pn * BM; bf16_t* base = O;
        float sc = 1.f; if (split_cols) { const int t = colt / split_cols; base += (size_t)t * split_stride; colt -= t * split_cols; if (t == 0) sc = scale0; }
        const int col0 = colt + wc * 32 + 8 * fq, bcol0 = u.pn * BM + wc * 32 + 8 * fq;
        f32x4 bv[2][2];
#pragma unroll
        for (int bj = 0; bj < 2; ++bj)
#pragma unroll
            for (int n = 0; n < 2; ++n) bv[bj][n] = bias ? *(const f32x4*)(bias + bcol0 + bj * HALF + 4 * n) : (f32x4){0.f, 0.f, 0.f, 0.f};
#pragma unroll
        for (int ai = 0; ai < 2; ++ai)
#pragma unroll
            for (int m = 0; m < 4; ++m) { bf16_t* rowp = base + (size_t)(row0 + ai * HALF + m * 16) * ldc + col0;
#pragma unroll
                for (int bj = 0; bj < 2; ++bj) { f32x4 v0 = acc[ai][bj][m][0] + bv[bj][0], v1 = acc[ai][bj][m][1] + bv[bj][1];
                    if (ACT == 1) { f32x2 a = gelu_pk((f32x2){v0[0], v0[1]}), b = gelu_pk((f32x2){v0[2], v0[3]}), c = gelu_pk((f32x2){v1[0], v1[1]}), d = gelu_pk((f32x2){v1[2], v1[3]});
                        v0 = (f32x4){a.x, a.y, b.x, b.y}; v1 = (f32x4){c.x, c.y, d.x, d.y}; }
                    v0 = v0 * sc; v1 = v1 * sc; u32x4 w; w.x = cvt_pk_bf16(v0[0], v0[1]); w.y = cvt_pk_bf16(v0[2], v0[3]); w.z = cvt_pk_bf16(v1[0], v1[1]); w.w = cvt_pk_bf16(v1[2], v1[3]);
                    *(u32x4*)(rowp + bj * HALF) = w; } }
    }
};
template <class Epi, class Sched, bool ALIGN_EPI = false, bool SP2 = false>
__device__ __forceinline__ void gemm_phase(PG8_LAS unsigned char* lds, const Gemm g, const Sched& S, const Epi& E) {
    int tid_ = threadIdx.x; asm volatile("" : "+v"(tid_)); const int tid = tid_, wid = __builtin_amdgcn_readfirstlane(tid >> 6), lane = tid & 63, wr = wid >> 2, wc = wid & 3, fr = lane & 15, fq = lane >> 4;
    const int K = g.K, nt = K / BK;
    unsigned voffA[2], voffB[2];
#pragma unroll
    for (int i = 0; i < 2; ++i) { int R, C; stage_rc(tid * 16 + i * 8192, R, C); const int Rb = Epi::PERM ? ((R & ~31) + perm32(R & 31)) : R;
        voffA[i] = (unsigned)(R * K + C) * 2u; voffB[i] = (unsigned)(Rb * K + C) * 2u; }
    const size_t kstep = (size_t)(BK * 2);
    const size_t hstep = (size_t)HALF * K * 2;
    const size_t tstep = 2 * hstep;
    const unsigned ldsw = (unsigned)wid * 1024u;
    const int aoff = lds_byte(wr * 64 + fr, fq * 8), boff = lds_byte(wc * 32 + fr, fq * 8);
#define PG8_SA(b, h) (((b) * 2 + (h)) * HTB)
#define PG8_SB(b, h) ((4 + (b) * 2 + (h)) * HTB)
#define PG8_STAGE(bufoff, gbase, voff) do { _Pragma("unroll") for (int _i = 0; _i < 2; ++_i) \
        __builtin_amdgcn_global_load_lds((const unsigned*)((const char*)(gbase) + (voff)[_i]), (PG8_LAS unsigned*)(lds + (bufoff) + ldsw + _i * 8192), 16, 0, 0); } while (0)
#define PG8_LDA(dst, b, h) do { _Pragma("unroll") for (int m = 0; m < 4; ++m) _Pragma("unroll") for (int k = 0; k < 2; ++k) dst[m][k] = *(const PG8_LAS bf16x8*)(lds + PG8_SA(b, h) + aoff + m * 2048 + k * 1024); } while (0)
#define PG8_LDB(dst, b, h) do { _Pragma("unroll") for (int n = 0; n < 2; ++n) _Pragma("unroll") for (int k = 0; k < 2; ++k) dst[n][k] = *(const PG8_LAS bf16x8*)(lds + PG8_SB(b, h) + boff + n * 2048 + k * 1024); } while (0)
#define PG8_MMA(ai, bj, At, Bt) do { __builtin_amdgcn_s_setprio(1); _Pragma("unroll") for (int m = 0; m < 4; ++m) _Pragma("unroll") for (int n = 0; n < 2; ++n) _Pragma("unroll") for (int k = 0; k < 2; ++k) \
        acc[ai][bj][m][n] = __builtin_amdgcn_mfma_f32_16x16x32_bf16(Bt[n][k], At[m][k], acc[ai][bj][m][n], 0, 0, 0); __builtin_amdgcn_s_setprio(0); } while (0)
#define PG8_WAIT_V(n) asm volatile("s_waitcnt vmcnt(" #n ")" ::: "memory")
#define PG8_WAIT_L(n) asm volatile("s_waitcnt lgkmcnt(" #n ")" ::: "memory")
#define PG8_BAR __builtin_amdgcn_s_barrier()
#define PG8_SCHED __builtin_amdgcn_sched_barrier(0)
    Unit cur, nxt; int ui = 0;
    if (!S.next(0, cur)) return;
    f32x4 acc[2][2][4][2];
#pragma unroll
    for (int a = 0; a < 2; ++a)
#pragma unroll
        for (int b = 0; b < 2; ++b)
#pragma unroll
            for (int m = 0; m < 4; ++m)
#pragma unroll
                for (int n = 0; n < 2; ++n) acc[a][b][m][n] = (f32x4){0.f, 0.f, 0.f, 0.f};
    bf16x8 At[4][2], B0[2][2], B1[2][2];
    const char* cA = (const char*)g.A + (size_t)cur.pm * tstep; const char* cB = (const char*)g.Bt + (size_t)cur.pn * tstep;
    S.a_ready(cur);
    if constexpr (SP2) {
        PG8_STAGE(PG8_SB(0, 0), cB, voffB); PG8_STAGE(PG8_SB(0, 1), cB + hstep, voffB); PG8_STAGE(PG8_SA(0, 0), cA, voffA); PG8_STAGE(PG8_SA(0, 1), cA + hstep, voffA);
        if (wr == 1) PG8_BAR;
        PG8_WAIT_V(2); PG8_BAR;
        PG8_STAGE(PG8_SB(1, 0), cB + kstep, voffB); PG8_STAGE(PG8_SA(1, 0), cA + kstep, voffA); PG8_STAGE(PG8_SB(1, 1), cB + hstep + kstep, voffB);
        PG8_WAIT_V(6); PG8_BAR;
    } else {
        PG8_STAGE(PG8_SB(0, 0), cB, voffB); PG8_STAGE(PG8_SA(0, 0), cA, voffA); PG8_STAGE(PG8_SB(0, 1), cB + hstep, voffB); PG8_STAGE(PG8_SA(0, 1), cA + hstep, voffA);
        if (wr == 1) PG8_BAR;
        PG8_WAIT_V(4); PG8_BAR;
        PG8_STAGE(PG8_SB(1, 0), cB + kstep, voffB); PG8_STAGE(PG8_SA(1, 0), cA + kstep, voffA); PG8_STAGE(PG8_SB(1, 1), cB + hstep + kstep, voffB);
        PG8_WAIT_V(6); PG8_BAR;
    }
    for (;;) {
        const bool has_next = S.next(ui + 1, nxt);
        const char* nA = has_next ? (const char*)g.A + (size_t)nxt.pm * tstep : cA; const char* nB = has_next ? (const char*)g.Bt + (size_t)nxt.pn * tstep : cB;
        for (int t = 0; t < nt; t += 2) {
            const bool last = (t == nt - 2);
            const char* a1 = cA + (size_t)(t + 1) * kstep;
            const char* a2 = last ? nA : cA + (size_t)(t + 2) * kstep; const char* b2 = last ? nB : cB + (size_t)(t + 2) * kstep;
            const char* a3 = a2 + kstep; const char* b3 = b2 + kstep;
            if (last && has_next) S.a_ready(nxt);
            if constexpr (SP2) {
            PG8_LDB(B0, 0, 0); PG8_LDB(B1, 0, 1); PG8_SCHED; PG8_LDA(At, 0, 0); PG8_STAGE(PG8_SA(1, 1), a1 + hstep, voffA);
            PG8_WAIT_V(8); PG8_WAIT_L(0); PG8_BAR; PG8_MMA(0, 0, At, B0); PG8_MMA(0, 1, At, B1); PG8_BAR; PG8_SCHED;
            PG8_LDA(At, 0, 1); PG8_STAGE(PG8_SB(0, 0), b2, voffB); PG8_STAGE(PG8_SB(0, 1), b2 + hstep, voffB); PG8_STAGE(PG8_SA(0, 0), a2, voffA);
            PG8_WAIT_V(8); PG8_WAIT_L(0); PG8_BAR; PG8_MMA(1, 0, At, B0); PG8_MMA(1, 1, At, B1); PG8_BAR; PG8_SCHED;
            PG8_LDB(B0, 1, 0); PG8_LDB(B1, 1, 1); PG8_SCHED; PG8_LDA(At, 1, 0); PG8_STAGE(PG8_SA(0, 1), a2 + hstep, voffA);
            PG8_WAIT_V(8); PG8_WAIT_L(0); PG8_BAR; PG8_MMA(0, 0, At, B0); PG8_MMA(0, 1, At, B1); PG8_BAR; PG8_SCHED;
            PG8_LDA(At, 1, 1); PG8_STAGE(PG8_SB(1, 0), b3, voffB); PG8_STAGE(PG8_SB(1, 1), b3 + hstep, voffB); PG8_STAGE(PG8_SA(1, 0), a3, voffA);
            PG8_WAIT_V(8); PG8_WAIT_L(0); PG8_BAR; PG8_MMA(1, 0, At, B0); PG8_MMA(1, 1, At, B1); PG8_BAR; PG8_SCHED;
            } else {
            PG8_LDB(B0, 0, 0); PG8_SCHED; PG8_LDA(At, 0, 0); PG8_STAGE(PG8_SA(1, 1), a1 + hstep, voffA);
            PG8_WAIT_L(8); PG8_BAR; PG8_WAIT_L(0); PG8_MMA(0, 0, At, B0); PG8_BAR; PG8_SCHED;
            PG8_LDB(B1, 0, 1); PG8_STAGE(PG8_SB(0, 0), b2, voffB);
            PG8_BAR; PG8_WAIT_L(0); PG8_MMA(0, 1, At, B1); PG8_BAR;
            PG8_LDA(At, 0, 1); PG8_STAGE(PG8_SA(0, 0), a2, voffA);
            PG8_BAR; PG8_WAIT_L(0); PG8_MMA(1, 0, At, B0); PG8_BAR; PG8_SCHED;
            PG8_STAGE(PG8_SB(0, 1), b2 + hstep, voffB);
            PG8_WAIT_V(6); PG8_BAR; PG8_MMA(1, 1, At, B1); PG8_BAR;
            PG8_LDB(B0, 1, 0); PG8_SCHED; PG8_LDA(At, 1, 0); PG8_STAGE(PG8_SA(0, 1), a2 + hstep, voffA);
            PG8_WAIT_L(8); PG8_BAR; PG8_WAIT_L(0); PG8_MMA(0, 0, At, B0); PG8_BAR; PG8_SCHED;
            PG8_LDB(B1, 1, 1); PG8_STAGE(PG8_SB(1, 0), b3, voffB);
            PG8_BAR; PG8_WAIT_L(0); PG8_MMA(0, 1, At, B1); PG8_BAR;
            PG8_LDA(At, 1, 1); PG8_STAGE(PG8_SA(1, 0), a3, voffA);
            PG8_BAR; PG8_WAIT_L(0); PG8_MMA(1, 0, At, B0); PG8_BAR; PG8_SCHED;
            PG8_STAGE(PG8_SB(1, 1), b3 + hstep, voffB);
            PG8_WAIT_V(6); PG8_BAR; PG8_MMA(1, 1, At, B1); PG8_BAR;
            }
        }
        if constexpr (ALIGN_EPI) { if (wr == 0) PG8_BAR; }
        if constexpr (!Epi::AFTER_DRAIN) { E(acc, cur, wr, wc, fr, fq); S.done(cur); }
        if (!has_next) break;
#pragma unroll
        for (int a = 0; a < 2; ++a)
#pragma unroll
            for (int b = 0; b < 2; ++b)
#pragma unroll
                for (int m = 0; m < 4; ++m)
#pragma unroll
                    for (int n = 0; n < 2; ++n) acc[a][b][m][n] = (f32x4){0.f, 0.f, 0.f, 0.f};
        cur = nxt; cA = nA; cB = nB; ++ui;
        if constexpr (ALIGN_EPI) { if (wr == 1) PG8_BAR; }
    }
    PG8_WAIT_V(0);
    if constexpr (!ALIGN_EPI) { if (wr == 0) PG8_BAR; }
    PG8_BAR;
    if constexpr (Epi::AFTER_DRAIN) { E.fused(acc, cur, wr, wc, fr, fq, lds, wid, lane); S.done(cur); }
#undef PG8_SA
#undef PG8_SB
#undef PG8_STAGE
#undef PG8_LDA
#undef PG8_LDB
#undef PG8_MMA
#undef PG8_WAIT_V
#undef PG8_WAIT_L
#undef PG8_BAR
#undef PG8_SCHED
}
}
namespace pg8 {
__device__ __forceinline__ float silu_f(float x) { return x * __builtin_amdgcn_rcpf(1.0f + __builtin_amdgcn_exp2f(-1.4426950408889634f * x)); }
struct EpiSplit4 {
    static constexpr bool PERM = true, AFTER_DRAIN = false;
    bf16_t* O; size_t split_stride; const float* sumsq; float qscale; int q_split, gate_split;
    __device__ __forceinline__ void operator()(const f32x4 (&acc)[2][2][4][2], const Unit& u, int wr, int wc, int fr, int fq) const {
        const int row0 = u.pm * BM + wr * 64 + fr; int colt = u.pn * BM; const int t = colt >> 10; colt &= 1023;
        bf16_t* base = O + (size_t)t * split_stride; const int col0 = colt + wc * 32 + 8 * fq;
        const float ts = (t == q_split) ? qscale : 1.f; const bool gate = (t == gate_split);
#pragma unroll
        for (int ai = 0; ai < 2; ++ai)
#pragma unroll
            for (int m = 0; m < 4; ++m) { const int row = row0 + ai * HALF + m * 16; float rs = ts;
                if (sumsq) rs *= 1.0f / sqrtf(sumsq[row] * (1.0f / 1024.0f) + 1e-6f);
                bf16_t* rowp = base + (size_t)row * 1024 + col0;
#pragma unroll
                for (int bj = 0; bj < 2; ++bj) { f32x4 v0 = acc[ai][bj][m][0] * rs, v1 = acc[ai][bj][m][1] * rs;
                    if (gate) { v0 = (f32x4){silu_f(v0[0]), silu_f(v0[1]), silu_f(v0[2]), silu_f(v0[3])}; v1 = (f32x4){silu_f(v1[0]), silu_f(v1[1]), silu_f(v1[2]), silu_f(v1[3])}; }
                    u32x4 w; w.x = cvt_pk_bf16(v0[0], v0[1]); w.y = cvt_pk_bf16(v0[2], v0[3]); w.z = cvt_pk_bf16(v1[0], v1[1]); w.w = cvt_pk_bf16(v1[2], v1[3]);
                    *(u32x4*)(rowp + bj * HALF) = w; } }
    }
};
struct EpiRes {
    static constexpr bool PERM = true, AFTER_DRAIN = false;
    const float* base; float* out; bf16_t* xa; float* sumsq;
    __device__ __forceinline__ void load_batch(f32x4 (&b)[2][2][2], int q, int row0, int col0) const {
#pragma unroll
        for (int mm = 0; mm < 2; ++mm)
#pragma unroll
            for (int bj = 0; bj < 2; ++bj) { const size_t off = (size_t)(row0 + (q >> 1) * HALF + (2 * (q & 1) + mm) * 16) * 1024 + col0 + bj * HALF; b[mm][bj][0] = *(const f32x4*)(base + off); b[mm][bj][1] = *(const f32x4*)(base + off + 4); }
    }
    __device__ __forceinline__ void store_batch(const f32x4 (&b)[2][2][2], const f32x4 (&acc)[2][2][4][2], int q, int row0, int col0, int fq, int pslot) const {
#pragma unroll
        for (int mm = 0; mm < 2; ++mm) { const int ai = q >> 1, m = 2 * (q & 1) + mm; const int row = row0 + ai * HALF + m * 16; const size_t off = (size_t)row * 1024 + col0; float ss = 0.f;
#pragma unroll
            for (int bj = 0; bj < 2; ++bj) { const f32x4 v0 = b[mm][bj][0] + acc[ai][bj][m][0], v1 = b[mm][bj][1] + acc[ai][bj][m][1];
                if (out) { *(f32x4*)(out + off + bj * HALF) = v0; *(f32x4*)(out + off + bj * HALF + 4) = v1; }
                ss += (v0[0] * v0[0] + v0[1] * v0[1]) + (v0[2] * v0[2] + v0[3] * v0[3]) + (v1[0] * v1[0] + v1[1] * v1[1]) + (v1[2] * v1[2] + v1[3] * v1[3]);
                if (xa) { u32x4 w; w.x = cvt_pk_bf16(v0[0], v0[1]); w.y = cvt_pk_bf16(v0[2], v0[3]); w.z = cvt_pk_bf16(v1[0], v1[1]); w.w = cvt_pk_bf16(v1[2], v1[3]);
                    *(u32x4*)(xa + off + bj * HALF) = w; } }
            if (sumsq) { ss += __shfl_xor(ss, 16); ss += __shfl_xor(ss, 32); if (fq == 0) atomicAdd(sumsq + row, ss); } }
    }
    __device__ __forceinline__ void operator()(const f32x4 (&acc)[2][2][4][2], const Unit& u, int wr, int wc, int fr, int fq) const {
        const int row0 = u.pm * BM + wr * 64 + fr; const int col0 = u.pn * BM + wc * 32 + 8 * fq; const int pslot = u.pn * 4 + wc;
        f32x4 b0[2][2][2], b1[2][2][2];
        load_batch(b0, 0, row0, col0);
        load_batch(b1, 1, row0, col0); store_batch(b0, acc, 0, row0, col0, fq, pslot);
        load_batch(b0, 2, row0, col0); store_batch(b1, acc, 1, row0, col0, fq, pslot);
        load_batch(b1, 3, row0, col0); store_batch(b0, acc, 2, row0, col0, fq, pslot);
        store_batch(b1, acc, 3, row0, col0, fq, pslot);
    }
};

struct EpiResBf {
    static constexpr bool PERM = true, AFTER_DRAIN = false;
    const bf16_t* resid; float* out;
    __device__ __forceinline__ void operator()(const f32x4 (&acc)[2][2][4][2], const Unit& u, int wr, int wc, int fr, int fq) const {
        const int row0 = u.pm * BM + wr * 64 + fr; const int col0 = u.pn * BM + wc * 32 + 8 * fq;
        u32x4 r[2][4][2];
#pragma unroll
        for (int ai = 0; ai < 2; ++ai)
#pragma unroll
            for (int m = 0; m < 4; ++m)
#pragma unroll
                for (int bj = 0; bj < 2; ++bj) r[ai][m][bj] = *(const u32x4*)(resid + (size_t)(row0 + ai * HALF + m * 16) * 1024 + col0 + bj * HALF);
#pragma unroll
        for (int ai = 0; ai < 2; ++ai)
#pragma unroll
            for (int m = 0; m < 4; ++m) { const size_t off = (size_t)(row0 + ai * HALF + m * 16) * 1024 + col0;
#pragma unroll
                for (int bj = 0; bj < 2; ++bj) { const u32x4 w = r[ai][m][bj];
                    const f32x4 b0 = {__uint_as_float(w.x << 16), __uint_as_float(w.x & 0xffff0000u), __uint_as_float(w.y << 16), __uint_as_float(w.y & 0xffff0000u)};
                    const f32x4 b1 = {__uint_as_float(w.z << 16), __uint_as_float(w.z & 0xffff0000u), __uint_as_float(w.w << 16), __uint_as_float(w.w & 0xffff0000u)};
                    *(f32x4*)(out + off + bj * HALF) = acc[ai][bj][m][0] + b0; *(f32x4*)(out + off + bj * HALF + 4) = acc[ai][bj][m][1] + b1; } }
    }
};

struct EpiB {
    static constexpr bool PERM = true, AFTER_DRAIN = false;
    bf16_t* O; size_t split_stride; const float* sumsq; const float* kg; const float* qg; const unsigned* rope; float qs; const float* subg; float post;
    __device__ __forceinline__ void operator()(const f32x4 (&acc)[2][2][4][2], const Unit& u, int wr, int wc, int fr, int fq) const {
        const int row0 = u.pm * BM + wr * 64 + fr; int colt = u.pn * BM; const int t = colt >> 10; colt &= 1023;
        bf16_t* base = O + (size_t)t * split_stride;
        float rsv[2][4];
#pragma unroll
        for (int ai = 0; ai < 2; ++ai)
#pragma unroll
            for (int m = 0; m < 4; ++m) rsv[ai][m] = __builtin_amdgcn_rsqf(sumsq[row0 + ai * HALF + m * 16] * (1.0f / 1024.0f) + 1e-6f);
        if (t & 1) {
            const int col0 = colt + wc * 32 + 8 * fq; const bool gate = (t == 3);
            f32x4 sg0 = {1.f, 1.f, 1.f, 1.f}, sg1 = sg0;
            if (gate) { sg0 = *(const f32x4*)(subg + wc * 32 + 8 * fq) * post; sg1 = *(const f32x4*)(subg + wc * 32 + 8 * fq + 4) * post; }
#pragma unroll
            for (int ai = 0; ai < 2; ++ai)
#pragma unroll
                for (int m = 0; m < 4; ++m) { const int row = row0 + ai * HALF + m * 16; const float rs = rsv[ai][m];
                    bf16_t* rowp = base + (size_t)row * 1024 + col0;
#pragma unroll
                    for (int bj = 0; bj < 2; ++bj) { f32x4 v0 = acc[ai][bj][m][0] * rs, v1 = acc[ai][bj][m][1] * rs;
                        if (gate) { v0 = (f32x4){silu_f(v0[0]), silu_f(v0[1]), silu_f(v0[2]), silu_f(v0[3])} * sg0; v1 = (f32x4){silu_f(v1[0]), silu_f(v1[1]), silu_f(v1[2]), silu_f(v1[3])} * sg1; }
                        u32x4 w; w.x = cvt_pk_bf16(v0[0], v0[1]); w.y = cvt_pk_bf16(v0[2], v0[3]); w.z = cvt_pk_bf16(v1[0], v1[1]); w.w = cvt_pk_bf16(v1[2], v1[3]);
                        *(u32x4*)(rowp + bj * HALF) = w; } }
        } else {
            const float* g = (t == 0) ? kg : qg; const float sc = (t == 2) ? qs : 1.0f;
            f32x4 g1[2], g2[2];
#pragma unroll
            for (int n = 0; n < 2; ++n) { g1[n] = *(const f32x4*)(g + 8 * fq + 4 * n) * sc; g2[n] = *(const f32x4*)(g + 32 + 8 * fq + 4 * n) * sc; }
            const int colc = colt + wc * 64 + 8 * fq;
#pragma unroll
            for (int ai = 0; ai < 2; ++ai)
#pragma unroll
                for (int m = 0; m < 4; ++m) { const int row = row0 + ai * HALF + m * 16; const float rs = rsv[ai][m];
                    f32x4 a1[2], a2[2]; float ss = 0.f;
#pragma unroll
                    for (int n = 0; n < 2; ++n) { a1[n] = acc[ai][0][m][n]; a2[n] = acc[ai][1][m][n];
                        ss += (a1[n][0] * a1[n][0] + a1[n][1] * a1[n][1]) + (a1[n][2] * a1[n][2] + a1[n][3] * a1[n][3]) + (a2[n][0] * a2[n][0] + a2[n][1] * a2[n][1]) + (a2[n][2] * a2[n][2] + a2[n][3] * a2[n][3]); }
                    ss += __shfl_xor(ss, 16); ss += __shfl_xor(ss, 32);
                    const float cr = rs * __builtin_amdgcn_rsqf(rs * rs * ss * (1.0f / 64.0f) + 1e-6f);
                    const u32x4* rp = (const u32x4*)(rope + (size_t)row * 32 + 8 * fq);
                    f32x4 o1[2], o2[2];
#pragma unroll
                    for (int n = 0; n < 2; ++n) { const f32x4 t1 = a1[n] * (g1[n] * cr), t2 = a2[n] * (g2[n] * cr); const u32x4 cw = rp[n];
                        const f32x4 cc = {__uint_as_float(cw.x << 16), __uint_as_float(cw.y << 16), __uint_as_float(cw.z << 16), __uint_as_float(cw.w << 16)};
                        const f32x4 sn = {__uint_as_float(cw.x & 0xffff0000u), __uint_as_float(cw.y & 0xffff0000u), __uint_as_float(cw.z & 0xffff0000u), __uint_as_float(cw.w & 0xffff0000u)};
                        o1[n] = t1 * cc - t2 * sn; o2[n] = t2 * cc + t1 * sn; }
                    bf16_t* rowp = base + (size_t)row * 1024 + colc; u32x4 w;
                    w.x = cvt_pk_bf16(o1[0][0], o1[0][1]); w.y = cvt_pk_bf16(o1[0][2], o1[0][3]); w.z = cvt_pk_bf16(o1[1][0], o1[1][1]); w.w = cvt_pk_bf16(o1[1][2], o1[1][3]); *(u32x4*)(rowp) = w;
                    w.x = cvt_pk_bf16(o2[0][0], o2[0][1]); w.y = cvt_pk_bf16(o2[0][2], o2[0][3]); w.z = cvt_pk_bf16(o2[1][0], o2[1][1]); w.w = cvt_pk_bf16(o2[1][2], o2[1][3]); *(u32x4*)(rowp + 32) = w; }
        }
    }
};
}
namespace mk {
#define LAS __attribute__((address_space(3)))
typedef unsigned short bf16;
typedef unsigned u32x4 __attribute__((ext_vector_type(4)));
typedef float f32x4 __attribute__((ext_vector_type(4)));
typedef float f32x16 __attribute__((ext_vector_type(16)));
typedef short bf16x8 __attribute__((ext_vector_type(8)));
typedef short s16x4 __attribute__((ext_vector_type(4)));
typedef short v4i16_t __attribute__((ext_vector_type(4)));
typedef float f32x2 __attribute__((ext_vector_type(2)));

constexpr int BATCH = 2, SEQ = 8192, DM = 1024, M = BATCH * SEQ, NWAVES = 8, NTHR = 512;
constexpr float EPS = 1e-6f, LOG2E = 1.4426950408889634f, QS = 0.125f * LOG2E;
constexpr float SB_MASS = 2.3283064365386963e-10f;
constexpr size_t MiB = 1u << 20;
constexpr size_t WS_SUMSQ = 0;
constexpr size_t WS_BAR = 64 * 1024;
constexpr size_t WS_ROPE = 1 * MiB;
constexpr size_t WS_WINA = 5 * MiB;
constexpr size_t WS_WOUTA = 13 * MiB;
constexpr size_t WS_WB = 15 * MiB;
constexpr size_t WS_WOUTB = 23 * MiB;
constexpr size_t WS_XA = 32 * MiB;
constexpr size_t WS_T = 64 * MiB;
constexpr size_t WS_O = 192 * MiB;
constexpr size_t WS_END = 224 * MiB;
constexpr size_t TSTRIDE = (size_t)M * DM;
constexpr int RING_BYTES = 131072, LDS_BYTES = 143360;
constexpr int DIFF_WSF = 137216, LDS_CTL = 141312;
constexpr int ATT_WSF = 98304, ATT_FLAGS = 98304 + 2048;

__device__ __forceinline__ int crow(int r, int hi) { return (r & 3) + 8 * (r >> 2) + 4 * hi; }
__device__ __forceinline__ unsigned cvtpk(float lo, float hi) { typedef __bf16 b2 __attribute__((ext_vector_type(2))); f32x2 v = {lo, hi}; b2 b = __builtin_convertvector(v, b2); return __builtin_bit_cast(unsigned, b); }
__device__ __forceinline__ float bf2f(unsigned short b) { return __uint_as_float((unsigned)b << 16); }
__device__ __forceinline__ s16x4 vtr(const LAS unsigned char* p) { return __builtin_bit_cast(s16x4, __builtin_amdgcn_ds_read_tr16_b64_v4i16((LAS v4i16_t*)p)); }
__device__ __forceinline__ float wave_sum(float v) {
#pragma unroll
    for (int o = 1; o < 64; o <<= 1) v += __shfl_xor(v, o);
    return v;
}
__device__ __forceinline__ float wave_max(float v) {
#pragma unroll
    for (int o = 1; o < 64; o <<= 1) v = fmaxf(v, __shfl_xor(v, o));
    return v;
}
#define MFMA32(a, b, c) __builtin_amdgcn_mfma_f32_32x32x16_bf16(a, b, c, 0, 0, 0)

struct KVMap { int kg0, kg1, vg0, vg1, kl0, kl1, vl0, vl1; };
struct KVStage { u32x4 k0, k1, v0, v1; };
__device__ __forceinline__ KVMap kv_map(int w, int lane) {
    KVMap m; const int krow = 16 * (w >> 1) + (lane >> 2); const int kc0 = 8 * (w & 1) + (lane & 3), kc1 = kc0 + 4;
    m.kg0 = krow * DM + 8 * kc0; m.kg1 = krow * DM + 8 * kc1;
    m.kl0 = (kc0 >> 3) * 8448 + (kc0 & 7) * 1056 + krow * 16; m.kl1 = (kc1 >> 3) * 8448 + (kc1 & 7) * 1056 + krow * 16;
    const int vr0 = 8 * w + (lane >> 4), vr1 = vr0 + 4, vch = lane & 15;
    m.vg0 = vr0 * DM + 8 * vch; m.vg1 = vr1 * DM + 8 * vch;
    m.vl0 = 17408 + (vch >> 2) * 4160 + vr0 * 64 + (vch & 3) * 16; m.vl1 = 17408 + (vch >> 2) * 4160 + vr1 * 64 + (vch & 3) * 16;
    return m;
}
__device__ __forceinline__ void kv_gload(KVStage& s, const bf16* Kt, const bf16* Vt, const KVMap& m) {
    s.k0 = *(const u32x4*)(Kt + m.kg0); s.k1 = *(const u32x4*)(Kt + m.kg1); s.v0 = *(const u32x4*)(Vt + m.vg0); s.v1 = *(const u32x4*)(Vt + m.vg1);
}
__device__ __forceinline__ void kv_lstore(const KVStage& s, LAS unsigned char* buf, const KVMap& m) {
    *(LAS u32x4*)(buf + m.kl0) = s.k0; *(LAS u32x4*)(buf + m.kl1) = s.k1; *(LAS u32x4*)(buf + m.vl0) = s.v0; *(LAS u32x4*)(buf + m.vl1) = s.v1;
}
__device__ __forceinline__ void qk_tile(f32x16& p0, f32x16& p1, const LAS unsigned char* kb, const bf16x8 (&qr)[4], float init) {
#pragma unroll
    for (int r = 0; r < 16; ++r) { p0[r] = init; p1[r] = init; }
    constexpr int RD = 3;
    bf16x8 kf[8];
#define KADDR(i) (kb + ((i) >> 1) * 2112 + ((i) & 1) * 512)
#pragma unroll
    for (int i = 0; i < RD; ++i) kf[i] = *(const LAS bf16x8*)KADDR(i);
    __builtin_amdgcn_sched_barrier(0);
#pragma unroll
    for (int i = 0; i < 8; ++i) {
        if (i + RD < 8) kf[i + RD] = *(const LAS bf16x8*)KADDR(i + RD);
        if (i & 1) p1 = MFMA32(kf[i], qr[i >> 1], p1); else p0 = MFMA32(kf[i], qr[i >> 1], p0);
        __builtin_amdgcn_sched_barrier(0);
    }
#undef KADDR
}
template <int NDB> __device__ __forceinline__ void pv_tile(f32x16 (&o)[NDB], const LAS unsigned char* vb, const f32x16& p0, const f32x16& p1) {
    bf16x8 pa[4];
    { u32x4 w;
      w = (u32x4){cvtpk(p0[0], p0[1]), cvtpk(p0[2], p0[3]), cvtpk(p0[4], p0[5]), cvtpk(p0[6], p0[7])}; pa[0] = __builtin_bit_cast(bf16x8, w);
      w = (u32x4){cvtpk(p0[8], p0[9]), cvtpk(p0[10], p0[11]), cvtpk(p0[12], p0[13]), cvtpk(p0[14], p0[15])}; pa[1] = __builtin_bit_cast(bf16x8, w);
      w = (u32x4){cvtpk(p1[0], p1[1]), cvtpk(p1[2], p1[3]), cvtpk(p1[4], p1[5]), cvtpk(p1[6], p1[7])}; pa[2] = __builtin_bit_cast(bf16x8, w);
      w = (u32x4){cvtpk(p1[8], p1[9]), cvtpk(p1[10], p1[11]), cvtpk(p1[12], p1[13]), cvtpk(p1[14], p1[15])}; pa[3] = __builtin_bit_cast(bf16x8, w); }
    constexpr int N = 4 * NDB, RD = 3;
    s16x4 lo[N], hi[N];
#define VADDR(i) (vb + ((i) % NDB) * 4160 + ((i) / NDB) * 1024)
#pragma unroll
    for (int i = 0; i < RD; ++i) { lo[i] = vtr(VADDR(i)); hi[i] = vtr(VADDR(i) + 512); }
    __builtin_amdgcn_sched_barrier(0);
#pragma unroll
    for (int i = 0; i < N; ++i) {
        if (i + RD < N) { lo[i + RD] = vtr(VADDR(i + RD)); hi[i + RD] = vtr(VADDR(i + RD) + 512); }
        const bf16x8 vf = {lo[i][0], lo[i][1], lo[i][2], lo[i][3], hi[i][0], hi[i][1], hi[i][2], hi[i][3]};
        o[i % NDB] = MFMA32(pa[i / NDB], vf, o[i % NDB]);
        __builtin_amdgcn_sched_barrier(0);
    }
#undef VADDR
}
template <int MODE> __device__ __forceinline__ void row_pass(const LAS float* E, int tid, size_t grow0, int col0, const bf16* G, bf16* O, const float* subg, float post) {
    const int row = tid >> 2, seg = tid & 3; const LAS float* e = E + row * 132 + 32 * seg;
    float v[32];
#pragma unroll
    for (int i = 0; i < 8; ++i) { const f32x4 x = *(const LAS f32x4*)(e + 4 * i); v[4 * i] = x[0]; v[4 * i + 1] = x[1]; v[4 * i + 2] = x[2]; v[4 * i + 3] = x[3]; }
    if (MODE == 1) { float ss = 0.f;
#pragma unroll
        for (int i = 0; i < 32; ++i) ss += v[i] * v[i];
        ss += __shfl_xor(ss, 1); ss += __shfl_xor(ss, 2);
        const float rstd = __builtin_amdgcn_rsqf(ss * (1.0f / 128.0f) + EPS);
#pragma unroll
        for (int i = 0; i < 32; ++i) v[i] *= rstd; }
    const size_t off = (grow0 + row) * DM + col0 + 32 * seg;
#pragma unroll
    for (int i = 0; i < 4; ++i) { const u32x4 g = *(const u32x4*)(G + off + 8 * i); u32x4 w;
#pragma unroll
        for (int j = 0; j < 4; ++j) { const float lo = v[8 * i + 2 * j] * __uint_as_float(g[j] << 16), hi = v[8 * i + 2 * j + 1] * __uint_as_float(g[j] & 0xffff0000u); w[j] = cvtpk(lo, hi); }
        *(u32x4*)(O + off + 8 * i) = w; }
}

#define XB_TMO      128
#define XB_XCNT(j)  (256  + 64 * (j))
#define XB_XSUB(j)  (1280 + 64 * (j))
#define XB_XGEN(j)  (2304 + 64 * (j))
#define XB_TOP      3328
#define XB_TOPGEN   3392
#define XCD_BAR_WORDS 3456
#define XB_SPIN_CAP (1u << 18)

__device__ __forceinline__ unsigned xb_ld(unsigned* p)              { return __hip_atomic_load(p, __ATOMIC_RELAXED, __HIP_MEMORY_SCOPE_AGENT); }
__device__ __forceinline__ unsigned xb_add(unsigned* p, unsigned v) { return __hip_atomic_fetch_add(p, v, __ATOMIC_RELAXED, __HIP_MEMORY_SCOPE_AGENT); }
__device__ __forceinline__ unsigned xb_xcc_id() { return (unsigned)__builtin_amdgcn_s_getreg((3 << 11) | 20) & 0xFu; }
#define XB_SPIN(cond, bar) do { unsigned _sp = 0; while (cond) { __builtin_amdgcn_s_sleep(1); \
    if ((++_sp & 255u) == 0u) { if (xb_ld(&(bar)[XB_TMO])) break; if (_sp > XB_SPIN_CAP) { atomicAdd(&(bar)[XB_TMO], 1u); break; } } } } while (0)

struct XcdBarrier {
    unsigned* bar; unsigned x;
    volatile LAS unsigned* st;
};

__device__ __forceinline__ XcdBarrier xcd_barrier_post(unsigned* bar, volatile LAS unsigned* st) {
    XcdBarrier b; b.bar = bar; b.x = xb_xcc_id(); b.st = st;
    if (threadIdx.x == 0) (void)xb_add(&bar[XB_XCNT(b.x)], 1u);
    return b;
}
__device__ __forceinline__ void xcd_barrier_complete(unsigned* bar, unsigned x, unsigned& nloc, unsigned& nx) {
    const unsigned G = gridDim.x * gridDim.y * gridDim.z;
    unsigned sum, cnt, mine, sp = 0u;
    for (;;) {
        sum = 0u; cnt = 0u; mine = 0u;
#pragma unroll
        for (unsigned j = 0; j < 16; ++j) { const unsigned c = xb_ld(&bar[XB_XCNT(j)]); sum += c; cnt += (c > 0u) ? 1u : 0u; mine = (j == x) ? c : mine; }
        if (sum == G) break;
        __builtin_amdgcn_s_sleep(1);
        if ((++sp & 255u) == 0u) { if (xb_ld(&bar[XB_TMO])) break; if (sp > XB_SPIN_CAP) { atomicAdd(&bar[XB_TMO], 1u); break; } }
    }
    nloc = mine > 0u ? mine : 1u; nx = cnt > 0u ? cnt : 1u;
}

__device__ __forceinline__ void xcd_barrier(const XcdBarrier& b) {
    asm volatile("s_waitcnt vmcnt(0)" ::: "memory");
    __syncthreads();
    if (threadIdx.x == 0) {
        unsigned* bar = b.bar;
        __builtin_amdgcn_s_waitcnt(0);
        unsigned nloc = b.st[0], nx = b.st[1];
        if (nloc == 0u) { xcd_barrier_complete(bar, b.x, nloc, nx); b.st[0] = nloc; b.st[1] = nx; }
        const unsigned old = xb_add(&bar[XB_XSUB(b.x)], 1u);
        const unsigned gen = old / nloc;
        if (old + 1u == (gen + 1u) * nloc) {
            __builtin_amdgcn_fence(__ATOMIC_RELEASE, "agent");
            asm volatile("s_waitcnt vmcnt(0)" ::: "memory");
            const unsigned og = xb_add(&bar[XB_TOP], 1u);
            const unsigned tg = og / nx;
            if (og + 1u == (tg + 1u) * nx) xb_add(&bar[XB_TOPGEN], 1u);
            else XB_SPIN(xb_ld(&bar[XB_TOPGEN]) == tg, bar);
            __builtin_amdgcn_fence(__ATOMIC_ACQUIRE, "agent");
            xb_add(&bar[XB_XGEN(b.x)], 1u);
            asm volatile("s_waitcnt vmcnt(0)" ::: "memory");
        } else {
            XB_SPIN(xb_ld(&bar[XB_XGEN(b.x)]) == gen, bar);
            __builtin_amdgcn_fence(__ATOMIC_ACQUIRE, "agent");
            asm volatile("s_waitcnt vmcnt(0)" ::: "memory");
        }
    }
    __syncthreads();
}

__device__ __forceinline__ void stick_attn_phase(LAS unsigned char* lds, int vcu, int G, const bf16* Qt, const bf16* Kt, const bf16* Vt, const bf16* Gt, bf16* Ot) {
    int tid_ = threadIdx.x; asm volatile("" : "+v"(tid_)); const int tid = tid_, lane = tid & 63, w = __builtin_amdgcn_readfirstlane(tid >> 6), r32 = lane & 31, hi = lane >> 5;
    const int c = w >> 2, jw = w & 3;
    const KVMap map = kv_map(w, lane);
    const LAS unsigned char* kfb = lds + c * 8448 + hi * 1056 + r32 * 16;
    const LAS unsigned char* vfb = lds + 17408 + (2 * c) * 4160 + (4 * hi + ((lane & 15) >> 2)) * 64 + ((lane >> 4) & 1) * 32 + (lane & 3) * 8;
    LAS float* E = (LAS float*)lds;
    volatile LAS float* flags = (volatile LAS float*)(lds + ATT_FLAGS);
    for (int u = vcu; u < 1024; u += G) {
        const int bhp = u >> 6, qb = u & 63, b = bhp >> 3, hp = bhp & 7;
        const size_t rowbase = (size_t)b * SEQ; const int q0 = qb * 128, q0w = q0 + 32 * jw, qrow = q0w + r32, col0 = hp * 128;
        const int tmax = 2 * qb + 1, tw = (q0w + 30) >> 6;
        bf16x8 qr[4];
#pragma unroll
        for (int d0 = 0; d0 < 4; ++d0) qr[d0] = *(const bf16x8*)(Qt + (rowbase + qrow) * DM + col0 + c * 64 + d0 * 16 + hi * 8);
        f32x16 o[2];
#pragma unroll
        for (int r = 0; r < 16; ++r) { o[0][r] = 0.f; o[1][r] = 0.f; }
        float crun = 1.0f; bool active = true;
        KVStage st;
        kv_gload(st, Kt + (rowbase + 64 * tmax) * DM + col0, Vt + (rowbase + 64 * tmax) * DM + col0, map);
        kv_lstore(st, lds, map);
        __builtin_amdgcn_s_waitcnt(0);
        __syncthreads();
        int it = 0;
        for (int t = tmax; t >= 0; --t, ++it) {
            const int cur = it & 1;
            if (t > 0) kv_gload(st, Kt + (rowbase + 64 * (t - 1)) * DM + col0, Vt + (rowbase + 64 * (t - 1)) * DM + col0, map);
            if (active && t <= tw) {
                f32x16 p0, p1, l0, l1;
                qk_tile(p0, p1, kfb + cur * 34048, qr, 0.f);
                const bool need_mask = (64 * t + 63 >= q0w);
                const int kv0 = 64 * t;
#pragma unroll
                for (int r = 0; r < 16; ++r) {
                    { const float z = p0[r], e = __builtin_amdgcn_exp2f(-fabsf(z)), rr = __builtin_amdgcn_rcpf(1.0f + e), er = e * rr; float nb = (z >= 0.f) ? er : rr, bb = (z >= 0.f) ? rr : er;
                      if (need_mask && (kv0 + crow(r, hi) >= qrow)) { nb = 1.f; bb = 0.f; } l0[r] = nb; p0[r] = bb; }
                    { const float z = p1[r], e = __builtin_amdgcn_exp2f(-fabsf(z)), rr = __builtin_amdgcn_rcpf(1.0f + e), er = e * rr; float nb = (z >= 0.f) ? er : rr, bb = (z >= 0.f) ? rr : er;
                      if (need_mask && (kv0 + 32 + crow(r, hi) >= qrow)) { nb = 1.f; bb = 0.f; } l1[r] = nb; p1[r] = bb; }
                }
                float S[16];
#pragma unroll
                for (int g = 0; g < 4; ++g) {
                    const float s0 = (l0[4 * g] * l0[4 * g + 1]) * (l0[4 * g + 2] * l0[4 * g + 3]);
                    const float s1 = (l1[4 * g] * l1[4 * g + 1]) * (l1[4 * g + 2] * l1[4 * g + 3]);
                    auto ra = __builtin_amdgcn_permlane32_swap(__float_as_uint(s0), __float_as_uint(s0), false, false);
                    auto rb = __builtin_amdgcn_permlane32_swap(__float_as_uint(s1), __float_as_uint(s1), false, false);
                    S[2 * g] = __uint_as_float(ra[0]); S[2 * g + 1] = __uint_as_float(ra[1]); S[8 + 2 * g] = __uint_as_float(rb[0]); S[8 + 2 * g + 1] = __uint_as_float(rb[1]);
                }
                float suf[16]; suf[15] = crun;
#pragma unroll
                for (int g = 14; g >= 0; --g) suf[g] = suf[g + 1] * S[g + 1];
                crun = suf[0] * S[0];
#pragma unroll
                for (int g = 0; g < 4; ++g) {
                    { const float e3 = hi ? suf[2 * g + 1] : suf[2 * g], e2 = e3 * l0[4 * g + 3], e1 = e2 * l0[4 * g + 2], e0 = e1 * l0[4 * g + 1];
                      p0[4 * g] *= e0; p0[4 * g + 1] *= e1; p0[4 * g + 2] *= e2; p0[4 * g + 3] *= e3; }
                    { const float e3 = hi ? suf[8 + 2 * g + 1] : suf[8 + 2 * g], e2 = e3 * l1[4 * g + 3], e1 = e2 * l1[4 * g + 2], e0 = e1 * l1[4 * g + 1];
                      p1[4 * g] *= e0; p1[4 * g + 1] *= e1; p1[4 * g + 2] *= e2; p1[4 * g + 3] *= e3; }
                }
                pv_tile<2>(o, vfb + cur * 34048, p0, p1);
                float mx = crun;
#pragma unroll
                for (int off = 1; off < 32; off <<= 1) mx = fmaxf(mx, __shfl_xor(mx, off));
                if (mx <= SB_MASS) active = false;
            }
            if (lane == 0) flags[cur * 8 + w] = active ? 0.f : 1.f;
            if (t > 0) kv_lstore(st, lds + (cur ^ 1) * 34048, map);
            __syncthreads();
            float fs = 0.f;
#pragma unroll
            for (int i = 0; i < 8; ++i) fs += flags[cur * 8 + i];
            if (fs >= 7.5f) break;
        }
#pragma unroll
        for (int db = 0; db < 2; ++db)
#pragma unroll
            for (int r = 0; r < 16; ++r) E[(32 * jw + crow(r, hi)) * 132 + 64 * c + 32 * db + r32] = o[db][r];
        __syncthreads();
        row_pass<0>(E, tid, rowbase + q0, col0, Gt, Ot, nullptr, 1.f);
        __syncthreads();
    }
}

#define DSB() __builtin_amdgcn_sched_barrier(0)
#define EXP4_ASM(P, R, S0, S1) asm volatile("v_exp_f32_e32 %0, %0\n\tv_exp_f32_e32 %1, %1\n\tv_exp_f32_e32 %2, %2\n\tv_exp_f32_e32 %3, %3\n\t" \
    "v_add_f32_e32 %4, %4, %0\n\tv_add_f32_e32 %5, %5, %1\n\tv_add_f32_e32 %4, %4, %2\n\tv_add_f32_e32 %5, %5, %3" \
    : "+v"(P[R]), "+v"(P[R + 1]), "+v"(P[R + 2]), "+v"(P[R + 3]), "+v"(S0), "+v"(S1))
#define EXP4_FIRST(P, S0, S1) do { P[0] = __builtin_amdgcn_exp2f(P[0]); P[1] = __builtin_amdgcn_exp2f(P[1]); P[2] = __builtin_amdgcn_exp2f(P[2]); P[3] = __builtin_amdgcn_exp2f(P[3]); \
    S0 = P[0] + P[2]; S1 = P[1] + P[3]; } while (0)
__device__ __forceinline__ void diff_tile(f32x16 (&o)[4], float& lsum, const LAS unsigned char* kb, const LAS unsigned char* vb, const bf16x8 (&qr)[4], float negm, bool need_mask, int lim) {
    f32x16 p0, p1;
#pragma unroll
    for (int r = 0; r < 16; ++r) { p0[r] = negm; p1[r] = negm; }
    bf16x8 kf[8];
#define KADDR(i) (kb + ((i) & 3) * 2112 + ((i) >> 2) * 512)
#define VADDR(i) (vb + ((i) & 3) * 4160 + ((i) >> 2) * 1024)
    kf[0] = *(const LAS bf16x8*)KADDR(0); kf[1] = *(const LAS bf16x8*)KADDR(1); kf[2] = *(const LAS bf16x8*)KADDR(2);
    DSB();
#pragma unroll
    for (int i = 0; i < 4; ++i) { kf[i + 3] = *(const LAS bf16x8*)KADDR(i + 3); p0 = MFMA32(kf[i], qr[i], p0); DSB(); }
    float s0, s1, s2, s3;
    s16x4 lo[16], hh[16];
    kf[7] = *(const LAS bf16x8*)KADDR(7); p1 = MFMA32(kf[4], qr[0], p1);
    if (need_mask) {
#pragma unroll
        for (int r = 0; r < 16; ++r) if ((r & 3) + 8 * (r >> 2) > lim) p0[r] = -INFINITY; }
    EXP4_FIRST(p0, s0, s1); DSB();
    p1 = MFMA32(kf[5], qr[1], p1); EXP4_ASM(p0, 4, s0, s1); DSB();
    p1 = MFMA32(kf[6], qr[2], p1); EXP4_ASM(p0, 8, s0, s1); lo[0] = vtr(VADDR(0)); hh[0] = vtr(VADDR(0) + 512); DSB();
    p1 = MFMA32(kf[7], qr[3], p1); EXP4_ASM(p0, 12, s0, s1); lo[1] = vtr(VADDR(1)); hh[1] = vtr(VADDR(1) + 512); DSB();
    bf16x8 pa[4];
    { u32x4 w;
      w = (u32x4){cvtpk(p0[0], p0[1]), cvtpk(p0[2], p0[3]), cvtpk(p0[4], p0[5]), cvtpk(p0[6], p0[7])}; pa[0] = __builtin_bit_cast(bf16x8, w);
      w = (u32x4){cvtpk(p0[8], p0[9]), cvtpk(p0[10], p0[11]), cvtpk(p0[12], p0[13]), cvtpk(p0[14], p0[15])}; pa[1] = __builtin_bit_cast(bf16x8, w); }
    lo[2] = vtr(VADDR(2)); hh[2] = vtr(VADDR(2) + 512);
    DSB();
#define PVSTEP(i) do { if ((i) + 3 < 16) { lo[(i) + 3] = vtr(VADDR((i) + 3)); hh[(i) + 3] = vtr(VADDR((i) + 3) + 512); } \
        { const bf16x8 vf_ = {lo[i][0], lo[i][1], lo[i][2], lo[i][3], hh[i][0], hh[i][1], hh[i][2], hh[i][3]}; o[(i) & 3] = MFMA32(pa[(i) >> 2], vf_, o[(i) & 3]); } } while (0)
    PVSTEP(0);
    if (need_mask) {
#pragma unroll
        for (int r = 0; r < 16; ++r) if (32 + (r & 3) + 8 * (r >> 2) > lim) p1[r] = -INFINITY; }
    EXP4_FIRST(p1, s2, s3); DSB();
    PVSTEP(1); DSB();
    PVSTEP(2); EXP4_ASM(p1, 4, s2, s3); DSB();
    PVSTEP(3); DSB();
    PVSTEP(4); EXP4_ASM(p1, 8, s2, s3); DSB();
    PVSTEP(5); DSB();
    PVSTEP(6); EXP4_ASM(p1, 12, s2, s3); DSB();
    PVSTEP(7);
    { u32x4 w;
      w = (u32x4){cvtpk(p1[0], p1[1]), cvtpk(p1[2], p1[3]), cvtpk(p1[4], p1[5]), cvtpk(p1[6], p1[7])}; pa[2] = __builtin_bit_cast(bf16x8, w);
      w = (u32x4){cvtpk(p1[8], p1[9]), cvtpk(p1[10], p1[11]), cvtpk(p1[12], p1[13]), cvtpk(p1[14], p1[15])}; pa[3] = __builtin_bit_cast(bf16x8, w); }
    DSB();
#pragma unroll
    for (int i = 8; i < 16; ++i) { PVSTEP(i); DSB(); }
    lsum += (s0 + s1) + (s2 + s3);
#undef PVSTEP
#undef KADDR
#undef VADDR
}
__device__ __forceinline__ void diff_attn_phase(LAS unsigned char* lds, int vcu, int G, const bf16* Qt, const bf16* Kt, const bf16* Vt, const bf16* Gt, bf16* Ot,
                                                const float* qg, const float* kg, const float* lamp, const float* subg) {
    int tid_ = threadIdx.x; asm volatile("" : "+v"(tid_)); const int tid = tid_, lane = tid & 63, w = __builtin_amdgcn_readfirstlane(tid >> 6), r32 = lane & 31, hi = lane >> 5;
    const int c = w >> 2, jw = w & 3;
    float lam, post, negm;
    { float a = lamp[lane] * lamp[64 + lane], bb = lamp[128 + lane] * lamp[192 + lane]; a = wave_sum(a); bb = wave_sum(bb);
      const float lam_init = 0.8f - 0.6f * expf(-0.3f); lam = expf(a) - expf(bb) + lam_init; post = 1.0f - lam_init;
      const float gq = wave_max(fabsf(qg[lane])), gk = wave_max(fabsf(kg[lane])); negm = -(8.0f * gq * gk * LOG2E); }
    const KVMap map = kv_map(w, lane);
    const LAS unsigned char* kfb = lds + c * 8448 + hi * 1056 + r32 * 16;
    const LAS unsigned char* vfb = lds + 17408 + (4 * hi + ((lane & 15) >> 2)) * 64 + ((lane >> 4) & 1) * 32 + (lane & 3) * 8;
    LAS float* E = (LAS float*)lds;
    LAS float* wsf = (LAS float*)(lds + DIFF_WSF) + w * 64;
    for (int pi = vcu; pi < 512; pi += G) {
        const int bh = pi >> 5, jj = pi & 31, b = bh >> 3, h = bh & 7;
        const size_t rowbase = (size_t)b * SEQ; const int col0 = h * 128;
        for (int uu = 0; uu < 2; ++uu) {
            const int qb = uu ? 63 - jj : jj, q0 = qb * 128, q0w = q0 + 32 * jw, qrow = q0w + r32, NTL = 2 * qb + 2;
            bf16x8 qr[4];
#pragma unroll
            for (int d0 = 0; d0 < 4; ++d0) qr[d0] = *(const bf16x8*)(Qt + (rowbase + qrow) * DM + col0 + c * 64 + d0 * 16 + hi * 8);
            f32x16 o[4];
#pragma unroll
            for (int r = 0; r < 16; ++r) { o[0][r] = 0.f; o[1][r] = 0.f; o[2][r] = 0.f; o[3][r] = 0.f; }
            float lsum = 0.f;
            KVStage st;
            kv_gload(st, Kt + rowbase * DM + col0, Vt + rowbase * DM + col0, map);
            kv_lstore(st, lds, map);
            kv_gload(st, Kt + (rowbase + 64) * DM + col0, Vt + (rowbase + 64) * DM + col0, map);
            kv_lstore(st, lds + 34048, map);
            __builtin_amdgcn_s_waitcnt(0);
            __syncthreads();
            const int NS = NTL >> 1;
            for (int u = 0; u < NS; ++u) {
                const int cb = (u & 1) * 68096, nb = cb ^ 68096; const bool more = (u + 1 < NS);
                if (more) kv_gload(st, Kt + (rowbase + 64 * (2 * u + 2)) * DM + col0, Vt + (rowbase + 64 * (2 * u + 2)) * DM + col0, map);
#pragma unroll
                for (int j = 0; j < 2; ++j) {
                    const int t = 2 * u + j;
                    if (64 * t <= q0w + 31) { int lim = qrow - 64 * t - 4 * hi; asm volatile("" : "+v"(lim));
                        diff_tile(o, lsum, kfb + cb + j * 34048, vfb + cb + j * 34048, qr, negm, 64 * t + 63 > q0w, lim); }
                    if (more) { kv_lstore(st, lds + nb + j * 34048, map);
                        if (j == 0) kv_gload(st, Kt + (rowbase + 64 * (2 * u + 3)) * DM + col0, Vt + (rowbase + 64 * (2 * u + 3)) * DM + col0, map); }
                }
                __syncthreads();
            }
            { auto rr = __builtin_amdgcn_permlane32_swap(__float_as_uint(lsum), __float_as_uint(lsum), false, false); lsum = __uint_as_float(rr[0]) + __uint_as_float(rr[1]); }
            if (hi == 0) wsf[r32] = (c ? lam : 1.0f) / lsum;
            float rli[16];
#pragma unroll
            for (int r = 0; r < 16; ++r) rli[r] = wsf[crow(r, hi)];
            if (c == 1) {
#pragma unroll
                for (int db = 0; db < 4; ++db)
#pragma unroll
                    for (int r = 0; r < 16; ++r) E[(32 * jw + crow(r, hi)) * 132 + 32 * db + r32] = o[db][r] * rli[r];
            }
            __syncthreads();
            if (c == 0) {
#pragma unroll
                for (int db = 0; db < 4; ++db)
#pragma unroll
                    for (int r = 0; r < 16; ++r) { LAS float* e = E + (32 * jw + crow(r, hi)) * 132 + 32 * db + r32; *e = o[db][r] * rli[r] - *e; }
            }
            __syncthreads();
            row_pass<1>(E, tid, rowbase + q0, col0, Gt, Ot, subg, post);
            __syncthreads();
        }
    }
}

__device__ __forceinline__ unsigned f2bf(float f) { unsigned u = __builtin_bit_cast(unsigned, f); return (u + 0x7fffu + ((u >> 16) & 1u)) >> 16; }
__device__ __forceinline__ unsigned pk2(float lo, float hi) { return f2bf(lo) | (f2bf(hi) << 16); }
__device__ __forceinline__ void p0_transpose_item(const float* W, const float* g, int K, int N, bf16* WT, int row_off, LAS float* scr, int item, int lane, int perm_below = 0) {
    const int nblk = N / 32, kb = item / nblk, nb = item % nblk, k0 = 64 * kb, n0 = 32 * nb;
    const int np0 = (n0 < perm_below) ? ((n0 & ~255) + 128 * ((n0 >> 5) & 1) + 32 * ((n0 & 255) >> 6)) : n0;
    float wv[32];
#pragma unroll
    for (int i = 0; i < 32; ++i) { const int kk = 2 * i + (lane >> 5); wv[i] = W[(size_t)(k0 + kk) * N + n0 + (lane & 31)]; }
#pragma unroll
    for (int i = 0; i < 32; ++i) { const int kk = 2 * i + (lane >> 5); scr[kk * 33 + (lane & 31)] = wv[i]; }
    asm volatile("s_waitcnt lgkmcnt(0)" ::: "memory");
    const int cc = lane & 7;
    f32x4 ga = {1.f, 1.f, 1.f, 1.f}, gb = ga;
    if (g) { ga = *(const f32x4*)(g + k0 + 8 * cc); gb = *(const f32x4*)(g + k0 + 8 * cc + 4); }
#pragma unroll
    for (int j = 0; j < 4; ++j) { const int n = (lane >> 3) + 8 * j; const LAS float* s = scr + (8 * cc) * 33 + n;
        u32x4 o; o.x = pk2(s[0 * 33] * ga[0], s[1 * 33] * ga[1]); o.y = pk2(s[2 * 33] * ga[2], s[3 * 33] * ga[3]); o.z = pk2(s[4 * 33] * gb[0], s[5 * 33] * gb[1]); o.w = pk2(s[6 * 33] * gb[2], s[7 * 33] * gb[3]);
        *(u32x4*)(WT + (size_t)(row_off + np0 + n) * K + k0 + 8 * cc) = o; }
    asm volatile("s_waitcnt lgkmcnt(0)" ::: "memory");
}
__device__ __forceinline__ void rms_row_to_bf16(const float* xrow, bf16* orow, int lane) {
    const f32x4* xr = (const f32x4*)xrow + lane;
    f32x4 v[4]; float s = 0.f;
#pragma unroll
    for (int j = 0; j < 4; ++j) { v[j] = xr[64 * j]; s += (v[j].x * v[j].x + v[j].y * v[j].y) + (v[j].z * v[j].z + v[j].w * v[j].w); }
    const float rstd = 1.0f / sqrtf(wave_sum(s) * (1.0f / DM) + EPS);
    unsigned long long* o8 = (unsigned long long*)orow + lane;
#pragma unroll
    for (int j = 0; j < 4; ++j) o8[64 * j] = (unsigned long long)pk2(v[j].x * rstd, v[j].y * rstd) | ((unsigned long long)pk2(v[j].z * rstd, v[j].w * rstd) << 32);
}
__device__ __forceinline__ void qk_norm_rope_item(bf16* Kraw, bf16* Qraw, const float* kg, const float* qg, const f32x2* rope, int idx) {
    const int row = idx >> 5, c32 = idx & 31; const bool isq = c32 >= 16;
    bf16* p = (isq ? Qraw : Kraw) + (size_t)row * DM + (c32 & 15) * 64; const float* g = isq ? qg : kg;
    u32x4 raw[8];
#pragma unroll
    for (int i = 0; i < 8; ++i) raw[i] = *(const u32x4*)(p + 8 * i);
    float v[64]; float ss = 0.f;
#pragma unroll
    for (int i = 0; i < 8; ++i)
#pragma unroll
        for (int j = 0; j < 4; ++j) { const float lo = __uint_as_float(raw[i][j] << 16), hi = __uint_as_float(raw[i][j] & 0xffff0000u); v[8 * i + 2 * j] = lo; v[8 * i + 2 * j + 1] = hi; ss += lo * lo + hi * hi; }
    const float rstd = (isq ? QS : 1.0f) / sqrtf(ss * (1.0f / 64.0f) + EPS);
    const f32x2* cs = rope + (size_t)row * 32;
#pragma unroll
    for (int i = 0; i < 32; ++i) { const f32x2 t = cs[i]; const float t1 = v[i] * rstd * g[i], t2 = v[i + 32] * rstd * g[i + 32]; v[i] = t1 * t.x - t2 * t.y; v[i + 32] = t2 * t.x + t1 * t.y; }
#pragma unroll
    for (int i = 0; i < 8; ++i) { u32x4 o;
#pragma unroll
        for (int j = 0; j < 4; ++j) o[j] = cvtpk(v[8 * i + 2 * j], v[8 * i + 2 * j + 1]);
        *(u32x4*)(p + 8 * i) = o; }
}

struct Args { const float* x; const int* pos; const float* a_norm_g; const float* a_w_in; const float* a_w_out; const float* kv_norm_g; const float* w_kv; const float* k_norm_g;
              const float* b_norm_g; const float* b_w_in; const float* b_q_norm_g; const float* b_lambda; const float* b_subln_g; const float* b_w_out; float* out; unsigned char* ws; int cg_seams; int pad_; };

__global__ void __launch_bounds__(NTHR, 2) yoco_fwd(Args a) {
    extern __shared__ __attribute__((aligned(16))) unsigned char lds_raw[];
    LAS unsigned char* lds = (LAS unsigned char*)lds_raw;
    cg::grid_group grid = cg::this_grid();
    const int tid = threadIdx.x, lane = tid & 63, wave = __builtin_amdgcn_readfirstlane(tid >> 6);
    const int G = gridDim.x, bx = blockIdx.x, vcu = (G % 8 == 0) ? (bx % 8) * (G / 8) + bx / 8 : bx;
    unsigned char* ws = a.ws;
    if (tid < 16) ((LAS unsigned*)(lds + LDS_CTL))[tid] = 0u;
    __syncthreads();
    const XcdBarrier bar = xcd_barrier_post((unsigned*)(ws + WS_BAR), (volatile LAS unsigned*)(lds + LDS_CTL));
    float* sumsq = (float*)(ws + WS_SUMSQ); unsigned* rope = (unsigned*)(ws + WS_ROPE);
    bf16* WinA = (bf16*)(ws + WS_WINA); bf16* WoutA = (bf16*)(ws + WS_WOUTA); bf16* WB = (bf16*)(ws + WS_WB); bf16* WoutB = (bf16*)(ws + WS_WOUTB);
    bf16* XA = (bf16*)(ws + WS_XA); bf16* T0 = (bf16*)(ws + WS_T); bf16* T1 = T0 + TSTRIDE; bf16* T2 = T1 + TSTRIDE; bf16* T3 = T2 + TSTRIDE; bf16* OB = (bf16*)(ws + WS_O);

    {
        LAS float* scr = (LAS float*)(lds + wave * 16384);
        const int gw = vcu * NWAVES + wave, NGW = G * NWAVES;
        constexpr int I_INA = 16 * 128, I_OUT = 16 * 32, I_KV = 16 * 64, I_BIN = 16 * 64;
        constexpr int NITEMS = I_INA + I_OUT + I_KV + I_BIN + I_OUT;
        for (int it = gw; it < NITEMS; it += NGW) {
            int r = it;
            if (r < I_INA) { p0_transpose_item(a.a_w_in, a.a_norm_g, DM, 4096, WinA, 0, scr, r, lane); continue; } r -= I_INA;
            if (r < I_OUT) { p0_transpose_item(a.a_w_out, nullptr, DM, DM, WoutA, 0, scr, r, lane); continue; } r -= I_OUT;
            if (r < I_KV) { p0_transpose_item(a.w_kv, a.kv_norm_g, DM, 2048, WB, 0, scr, r, lane, 1024); continue; } r -= I_KV;
            if (r < I_BIN) { p0_transpose_item(a.b_w_in, a.b_norm_g, DM, 2048, WB, 2048, scr, r, lane, 1024); continue; } r -= I_BIN;
            p0_transpose_item(a.b_w_out, nullptr, DM, DM, WoutB, 0, scr, r, lane);
        }
        for (int m = gw; m < M; m += 2 * NGW) {
            const f32x4* xa0 = (const f32x4*)(a.x + (size_t)m * DM) + lane; const int m1 = (m + NGW < M) ? m + NGW : m; const f32x4* xa1 = (const f32x4*)(a.x + (size_t)m1 * DM) + lane;
            f32x4 v0[4], v1[4]; float q0 = 0.f, q1 = 0.f;
#pragma unroll
            for (int j = 0; j < 4; ++j) { v0[j] = xa0[64 * j]; v1[j] = xa1[64 * j]; }
#pragma unroll
            for (int j = 0; j < 4; ++j) { q0 += (v0[j].x * v0[j].x + v0[j].y * v0[j].y) + (v0[j].z * v0[j].z + v0[j].w * v0[j].w); q1 += (v1[j].x * v1[j].x + v1[j].y * v1[j].y) + (v1[j].z * v1[j].z + v1[j].w * v1[j].w); }
            const float r0 = 1.0f / sqrtf(wave_sum(q0) * (1.0f / DM) + EPS), r1 = 1.0f / sqrtf(wave_sum(q1) * (1.0f / DM) + EPS);
            unsigned long long* o0 = (unsigned long long*)(XA + (size_t)m * DM) + lane; unsigned long long* o1 = (unsigned long long*)(XA + (size_t)m1 * DM) + lane;
#pragma unroll
            for (int j = 0; j < 4; ++j) { o0[64 * j] = (unsigned long long)pk2(v0[j].x * r0, v0[j].y * r0) | ((unsigned long long)pk2(v0[j].z * r0, v0[j].w * r0) << 32);
                o1[64 * j] = (unsigned long long)pk2(v1[j].x * r1, v1[j].y * r1) | ((unsigned long long)pk2(v1[j].z * r1, v1[j].w * r1) << 32); }
        }
        const int gt = vcu * NTHR + tid, NGT = G * NTHR;
        for (int idx = gt; idx < M * 32; idx += NGT) {
            const int row = idx >> 5, i = idx & 31;
            const float inv = (float)exp2(-(double)i * (13.287712379549449 / 32.0));
            const float ang = (float)a.pos[row] * inv;
            const double ad = (double)ang; const double kq = rint(ad * 0.15915494309189535);
            double rr = fma(-kq, 6.283185307179586, ad); rr = fma(-kq, 2.4492935982947064e-16, rr);
            const float rf = (float)rr;
            rope[idx] = pk2(cosf(rf), sinf(rf));
        }
    }
    if (a.cg_seams) grid.sync(); else xcd_barrier(bar);
    { pg8::Gemm g{XA, WinA, M, 4096, DM}; pg8::StaticOrder S; S.init(M, 4096, G, bx);
      pg8::EpiSplit4 E{T0, TSTRIDE, nullptr, QS, 0, 3};
      pg8::gemm_phase<pg8::EpiSplit4, pg8::StaticOrder, true, true>(lds, g, S, E); }
    if (a.cg_seams) grid.sync(); else xcd_barrier(bar);
    stick_attn_phase(lds, vcu, G, T0, T1, T2, T3, OB);
    if (a.cg_seams) grid.sync(); else xcd_barrier(bar);
    { pg8::Gemm g{OB, WoutA, M, DM, DM}; pg8::StaticOrder S; S.init(M, DM, G, bx);
      pg8::EpiRes E{a.x, nullptr, XA, sumsq};
      pg8::gemm_phase<pg8::EpiRes, pg8::StaticOrder, true, true>(lds, g, S, E); }
    if (a.cg_seams) grid.sync(); else xcd_barrier(bar);
    { pg8::Gemm g{XA, WB, M, 4096, DM}; pg8::StaticOrder S; S.init(M, 4096, G, bx);
      pg8::EpiB E{T0, TSTRIDE, sumsq, a.k_norm_g, a.b_q_norm_g, (const unsigned*)rope, QS, a.b_subln_g, 1.0f - (0.8f - 0.6f * expf(-0.3f))};
      pg8::gemm_phase<pg8::EpiB, pg8::StaticOrder, true, true>(lds, g, S, E); }
    if (a.cg_seams) grid.sync(); else xcd_barrier(bar);
    diff_attn_phase(lds, vcu, G, T2, T0, T1, T3, OB, a.b_q_norm_g, a.k_norm_g, a.b_lambda, a.b_subln_g);
    if (a.cg_seams) grid.sync(); else xcd_barrier(bar);
    { pg8::Gemm g{OB, WoutB, M, DM, DM}; pg8::StaticOrder S; S.init(M, DM, G, bx);
      pg8::EpiResBf E{XA, a.out};
      pg8::gemm_phase<pg8::EpiResBf, pg8::StaticOrder, true, true>(lds, g, S, E); }
}
}

extern "C" void kernel_launch(void* const* d_in, const int* in_sizes, int n_in, void* d_out, int out_size, void* d_ws, size_t ws_size, hipStream_t stream) {
    static int grid = 0;
    if (grid == 0) {
        if (n_in != 14 || in_sizes[0] != mk::M * mk::DM || out_size != mk::M * mk::DM || ws_size < mk::WS_END) { fprintf(stderr, "kernel_launch: unexpected shapes (n_in %d, ws %zu); nothing launched\n", n_in, ws_size); grid = -1; return; }
        int dev = 0, cus = 0, per_cu = 0;
        if (hipGetDevice(&dev) != hipSuccess || hipDeviceGetAttribute(&cus, hipDeviceAttributeMultiprocessorCount, dev) != hipSuccess) { grid = -1; return; }
        if (hipFuncSetAttribute((const void*)mk::yoco_fwd, hipFuncAttributeMaxDynamicSharedMemorySize, mk::LDS_BYTES) != hipSuccess) { fprintf(stderr, "kernel_launch: hipFuncSetAttribute failed\n"); grid = -1; return; }
        if (hipOccupancyMaxActiveBlocksPerMultiprocessor(&per_cu, (const void*)mk::yoco_fwd, mk::NTHR, mk::LDS_BYTES) != hipSuccess || per_cu < 1) { fprintf(stderr, "kernel_launch: occupancy query gave %d\n", per_cu); (void)hipGetLastError(); per_cu = 1; }
        grid = cus * per_cu;
    }
    if (grid < 0) return;
    (void)hipMemsetAsync((char*)d_ws, 0, 80 * 1024, stream);
    mk::Args a{};
    a.x = (const float*)d_in[0]; a.pos = (const int*)d_in[1]; a.a_norm_g = (const float*)d_in[2]; a.a_w_in = (const float*)d_in[3]; a.a_w_out = (const float*)d_in[4];
    a.kv_norm_g = (const float*)d_in[5]; a.w_kv = (const float*)d_in[6]; a.k_norm_g = (const float*)d_in[7]; a.b_norm_g = (const float*)d_in[8]; a.b_w_in = (const float*)d_in[9];
    a.b_q_norm_g = (const float*)d_in[10]; a.b_lambda = (const float*)d_in[11]; a.b_subln_g = (const float*)d_in[12]; a.b_w_out = (const float*)d_in[13];
    a.out = (float*)d_out; a.ws = (unsigned char*)d_ws;
    void* args[] = {&a};
    const hipError_t e = hipLaunchCooperativeKernel((const void*)mk::yoco_fwd, dim3(grid), dim3(mk::NTHR), args, mk::LDS_BYTES, stream);
    if (e != hipSuccess) fprintf(stderr, "kernel_launch: cooperative launch failed: %s (grid %d)\n", hipGetErrorString(e), grid);
}
```
